# Optimizing an MI355X kernel written in HIP

```python
import jax, jax.numpy as jnp
from jax import lax
import numpy as np

D_MODEL = 2048
BATCH = 4
SEQ = 4096
DEPTH = 1

A_HEADS = 8
A_HEAD_DIM = 128
A_WIDTH = A_HEADS * A_HEAD_DIM
CONV_WIDTH = 4
CHUNK_A = 64
B_GROUPS = 8
B_GROUP_DIM = 128
B_WIDTH = B_GROUPS * B_GROUP_DIM
CHUNK_B = 128
MIX_WIDTH = A_WIDTH + B_WIDTH
IN_SIZES = (3 * A_WIDTH, A_WIDTH, A_HEADS, A_HEADS, B_WIDTH, B_WIDTH, B_WIDTH)
IN_WIDTH = int(sum(IN_SIZES))
IN_SPLITS = tuple(int(s) for s in np.cumsum(IN_SIZES)[:-1])
EPS = 1e-6

kernel_name = "hymba_style_gdn_gmlp_hybrid"


def rms_norm(x, w):
    xf = x.astype(jnp.float32)
    y = xf * lax.rsqrt(jnp.mean(xf * xf, axis=-1, keepdims=True) + EPS)
    return (y * w.astype(jnp.float32)).astype(x.dtype)


def layer_norm(x, w, b):
    xf = x.astype(jnp.float32)
    mu = jnp.mean(xf, axis=-1, keepdims=True)
    var = jnp.mean(jnp.square(xf - mu), axis=-1, keepdims=True)
    y = (xf - mu) * lax.rsqrt(var + EPS)
    return (y * w.astype(jnp.float32) + b.astype(jnp.float32)).astype(x.dtype)


def l2_normalize(x):
    return x * lax.rsqrt(jnp.sum(x * x, axis=-1, keepdims=True) + EPS)


def causal_depthwise_conv(x, w):
    C = x.shape[-1]
    return lax.conv_general_dilated(
        x, w[:, None, :].astype(x.dtype), window_strides=(1,),
        padding=[(CONV_WIDTH - 1, 0)],
        dimension_numbers=("NWC", "WIO", "NWC"), feature_group_count=C)


def chunk_gated_delta_rule(q, k, v, g, beta):
    B, T, H, D = q.shape
    N, C = T // CHUNK_A, CHUNK_A
    chunk4 = lambda t: t.reshape(B, N, C, H, D).transpose(0, 3, 1, 2, 4)
    chunk3 = lambda t: t.reshape(B, N, C, H).transpose(0, 3, 1, 2)
    q = chunk4(q) * (D ** -0.5)
    k, v = chunk4(k), chunk4(v)
    beta, g = chunk3(beta), chunk3(g)
    kb = k * beta[..., None]
    vb = v * beta[..., None]
    gc = jnp.cumsum(g, axis=-1)
    incl = jnp.tril(jnp.ones((C, C), dtype=bool))
    strict = jnp.tril(jnp.ones((C, C), dtype=bool), k=-1)
    diff = gc[..., :, None] - gc[..., None, :]
    decay = jnp.where(incl, jnp.exp(jnp.where(incl, diff, 0.0)), 0.0)
    L = jnp.where(strict, jnp.einsum('bhnid,bhnjd->bhnij', kb, k) * decay, 0.0)
    rhs = jnp.concatenate([vb, kb * jnp.exp(gc)[..., None]], axis=-1)
    sol = lax.linalg.triangular_solve(L + jnp.eye(C, dtype=L.dtype), rhs,
                                      left_side=True, lower=True, unit_diagonal=True)
    u, w = sol[..., :D], sol[..., D:]
    attn = jnp.where(incl, jnp.einsum('bhnid,bhnjd->bhnij', q, k) * decay, 0.0)
    xs = tuple(jnp.moveaxis(t, 2, 0) for t in (q, k, u, w, attn, gc))

    def step(S, inp):
        qi, ki, ui, wi, ai, gi = inp
        v_new = ui - jnp.einsum('bhcd,bhde->bhce', wi, S)
        o = (jnp.einsum('bhcd,bhde->bhce', qi * jnp.exp(gi)[..., None], S)
             + jnp.einsum('bhij,bhje->bhie', ai, v_new))
        g_last = gi[..., -1]
        k_dec = ki * jnp.exp(g_last[..., None] - gi)[..., None]
        S = S * jnp.exp(g_last)[..., None, None] + jnp.einsum('bhcd,bhce->bhde', k_dec, v_new)
        return S, o

    S0 = jnp.zeros((B, H, D, D), dtype=jnp.float32)
    _, o = lax.scan(step, S0, xs)
    return o.transpose(1, 0, 3, 2, 4).reshape(B, T, H, D)


def chunked_causal_sgu(v, w_s, b_s):
    Bn, T, _ = v.shape
    N = T // CHUNK_B
    vc = v.reshape(Bn, N, CHUNK_B, B_GROUPS, B_GROUP_DIM)
    mask = jnp.tril(jnp.ones((CHUNK_B, CHUNK_B), dtype=bool))
    w_m = jnp.where(mask[None], w_s, 0.0).astype(v.dtype)
    s = jnp.einsum('gts,bnsgc->bntgc', w_m, vc) + b_s.T.astype(v.dtype)[None, None, :, :, None]
    return s.reshape(Bn, T, B_WIDTH)


def setup_inputs(seed: int = 0) -> dict:
    key = jax.random.key(seed)
    ks = jax.random.split(key, 14)
    f32 = jnp.float32
    x = jax.random.normal(ks[0], (BATCH, SEQ, D_MODEL), f32)
    norm_w = 1.0 + 0.02 * jax.random.normal(ks[1], (DEPTH, D_MODEL), f32)
    w_in = jax.random.normal(ks[2], (DEPTH, D_MODEL, IN_WIDTH), f32) * D_MODEL ** -0.5
    conv_w = jax.random.normal(ks[3], (DEPTH, CONV_WIDTH, 3 * A_WIDTH), f32) * CONV_WIDTH ** -0.5
    a_log = jnp.log(jax.random.uniform(ks[4], (DEPTH, A_HEADS), f32, 1.0, 16.0))
    dt = jnp.exp(jax.random.uniform(ks[5], (DEPTH, A_HEADS), f32,
                                    np.log(1e-3).astype(np.float32), np.log(1e-1).astype(np.float32)))
    dt_bias = dt + jnp.log(-jnp.expm1(-dt))
    head_norm_w = 1.0 + 0.02 * jax.random.normal(ks[6], (DEPTH, A_HEAD_DIM), f32)
    sgu_ln_w = 1.0 + 0.02 * jax.random.normal(ks[7], (DEPTH, B_WIDTH), f32)
    sgu_ln_b = 0.02 * jax.random.normal(ks[8], (DEPTH, B_WIDTH), f32)
    w_spatial = jax.random.normal(ks[9], (DEPTH, B_GROUPS, CHUNK_B, CHUNK_B), f32) * CHUNK_B ** -0.5
    b_spatial = 1.0 + 0.02 * jax.random.normal(ks[10], (DEPTH, B_GROUPS, CHUNK_B), f32)
    w_out = jax.random.normal(ks[11], (DEPTH, MIX_WIDTH, D_MODEL), f32) * MIX_WIDTH ** -0.5
    final_norm_w = 1.0 + 0.02 * jax.random.normal(ks[12], (D_MODEL,), f32)
    return {"x": x, "norm_w": norm_w, "w_in": w_in, "conv_w": conv_w, "a_log": a_log,
            "dt_bias": dt_bias, "head_norm_w": head_norm_w, "sgu_ln_w": sgu_ln_w,
            "sgu_ln_b": sgu_ln_b, "w_spatial": w_spatial, "b_spatial": b_spatial,
            "w_out": w_out, "final_norm_w": final_norm_w}


def reference(x, norm_w, w_in, conv_w, a_log, dt_bias, head_norm_w, sgu_ln_w,
              sgu_ln_b, w_spatial, b_spatial, w_out, final_norm_w):
    Bn, T, _ = x.shape
    h = x
    for l in range(DEPTH):
        xn = rms_norm(h, norm_w[l])
        proj = xn @ w_in[l].astype(x.dtype)
        qkv, z_a, b_raw, a_raw, u_b, v_b, z_b = jnp.split(proj, IN_SPLITS, axis=-1)

        qkv = jax.nn.silu(causal_depthwise_conv(qkv, conv_w[l])).astype(jnp.float32)
        q, k, v = jnp.split(qkv, 3, axis=-1)
        q = l2_normalize(q.reshape(Bn, T, A_HEADS, A_HEAD_DIM))
        k = l2_normalize(k.reshape(Bn, T, A_HEADS, A_HEAD_DIM))
        v = v.reshape(Bn, T, A_HEADS, A_HEAD_DIM)
        beta = jax.nn.sigmoid(b_raw.astype(jnp.float32))
        g = -jnp.exp(a_log[l].astype(jnp.float32)) * jax.nn.softplus(
            a_raw.astype(jnp.float32) + dt_bias[l].astype(jnp.float32))
        o_a = chunk_gated_delta_rule(q, k, v, g, beta)
        o_a = rms_norm(o_a, head_norm_w[l]).astype(x.dtype)
        o_a = (o_a * jax.nn.silu(z_a.reshape(Bn, T, A_HEADS, A_HEAD_DIM))).reshape(Bn, T, A_WIDTH)

        v_n = layer_norm(v_b, sgu_ln_w[l], sgu_ln_b[l])
        o_b = u_b * chunked_causal_sgu(v_n, w_spatial[l], b_spatial[l]) * jax.nn.silu(z_b)

        mix = jnp.concatenate([o_a, o_b], axis=-1) @ w_out[l].astype(x.dtype)
        h = h + mix
    return rms_norm(h, final_norm_w)
```

```cpp
#include <hip/hip_runtime.h>
#include <stdint.h>

namespace nv {
constexpr int BATCH = 4, SEQ = 4096, DM = 2048, M = BATCH * SEQ;
constexpr int AH = 8, AD = 128, AW = 1024, BW = 1024, INW = 7184, MIXW = 2048;
constexpr int OFF_QKV = 0, OFF_ZA = 3072, OFF_BRAW = 4096, OFF_ARAW = 4104, OFF_UB = 4112, OFF_VB = 5136, OFF_ZB = 6160;
constexpr float EPS = 1e-6f;
typedef unsigned short bf16;

__device__ __forceinline__ unsigned f2bf(float f) { unsigned u = __float_as_uint(f); return (u + 0x7fffu + ((u >> 16) & 1u)) >> 16; }
__device__ __forceinline__ float bf2f(bf16 b) { return __uint_as_float(((unsigned)b) << 16); }
__device__ __forceinline__ float silu(float x) { return x / (1.f + __expf(-x)); }
__device__ __forceinline__ float sigmoidf(float x) { return 1.f / (1.f + __expf(-x)); }
__device__ __forceinline__ float softplus(float x) { return fmaxf(x, 0.f) + log1pf(__expf(-fabsf(x))); }

__device__ __forceinline__ float block_sum_256(float v, float* red) {
    for (int o = 32; o >= 1; o >>= 1) v += __shfl_xor(v, o);
    const int w = threadIdx.x >> 6, l = threadIdx.x & 63;
    __syncthreads();
    if (l == 0) red[w] = v;
    __syncthreads();
    return red[0] + red[1] + red[2] + red[3];
}

__global__ void __launch_bounds__(256) k_rstd(const float* __restrict__ x, float* __restrict__ rstd) {
    __shared__ float red[4];
    const int m = blockIdx.x;
    const float* xr = x + (size_t)m * DM;
    float s = 0.f;
    for (int i = threadIdx.x; i < DM; i += 256) { float v = xr[i]; s += v * v; }
    s = block_sum_256(s, red);
    if (threadIdx.x == 0) rstd[m] = rsqrtf(s / DM + EPS);
}

template <int MODE>
__global__ void __launch_bounds__(256) k_gemm(const float* __restrict__ A, const float* __restrict__ B, int N, int K,
                                              const float* __restrict__ rstd, const float* __restrict__ nw,
                                              bf16* __restrict__ outb, float* __restrict__ ab,
                                              const float* __restrict__ resid, float* __restrict__ outf) {
    __shared__ float As[16][132];
    __shared__ float Bs[16][132];
    const int tid = threadIdx.x, tx = tid & 15, ty = tid >> 4;
    const int m0 = blockIdx.y * 128, n0 = blockIdx.x * 128;
    float acc[8][8];
#pragma unroll
    for (int i = 0; i < 8; ++i)
#pragma unroll
        for (int j = 0; j < 8; ++j) acc[i][j] = 0.f;
    const int arow = tid >> 1, akoff = (tid & 1) * 8;
    const int bk = tid >> 4, bnoff = (tid & 15) * 8;
    const float rs = (MODE == 0) ? rstd[m0 + arow] : 1.f;
    for (int k0 = 0; k0 < K; k0 += 16) {
        {
            const float* ap = A + (size_t)(m0 + arow) * K + k0 + akoff;
            float4 a0 = *(const float4*)ap, a1 = *(const float4*)(ap + 4);
            float av[8] = {a0.x, a0.y, a0.z, a0.w, a1.x, a1.y, a1.z, a1.w};
#pragma unroll
            for (int j = 0; j < 8; ++j) {
                float v = av[j];
                if (MODE == 0) v = v * rs * nw[k0 + akoff + j];
                As[akoff + j][arow] = v;
            }
            const int n = n0 + bnoff;
            float4 b0 = make_float4(0.f, 0.f, 0.f, 0.f), b1 = b0;
            if (n < N) { const float* bp = B + (size_t)(k0 + bk) * N + n; b0 = *(const float4*)bp; b1 = *(const float4*)(bp + 4); }
            *(float4*)&Bs[bk][bnoff] = b0; *(float4*)&Bs[bk][bnoff + 4] = b1;
        }
        __syncthreads();
#pragma unroll
        for (int k = 0; k < 16; ++k) {
            float4 a0 = *(const float4*)&As[k][ty * 8], a1 = *(const float4*)&As[k][ty * 8 + 4];
            float4 b0 = *(const float4*)&Bs[k][tx * 8], b1 = *(const float4*)&Bs[k][tx * 8 + 4];
            float av[8] = {a0.x, a0.y, a0.z, a0.w, a1.x, a1.y, a1.z, a1.w};
            float bv[8] = {b0.x, b0.y, b0.z, b0.w, b1.x, b1.y, b1.z, b1.w};
#pragma unroll
            for (int i = 0; i < 8; ++i)
#pragma unroll
                for (int j = 0; j < 8; ++j) acc[i][j] = fmaf(av[i], bv[j], acc[i][j]);
        }
        __syncthreads();
    }
    const int n = n0 + tx * 8;
    if (n >= N) return;
#pragma unroll
    for (int i = 0; i < 8; ++i) {
        const int m = m0 + ty * 8 + i;
        if (MODE == 0) {
            uint4 w;
            w.x = f2bf(acc[i][0]) | (f2bf(acc[i][1]) << 16); w.y = f2bf(acc[i][2]) | (f2bf(acc[i][3]) << 16);
            w.z = f2bf(acc[i][4]) | (f2bf(acc[i][5]) << 16); w.w = f2bf(acc[i][6]) | (f2bf(acc[i][7]) << 16);
            *(uint4*)(outb + (size_t)m * N + n) = w;
            if (n == OFF_BRAW || n == OFF_ARAW) {
#pragma unroll
                for (int j = 0; j < 8; ++j) ab[(size_t)m * 16 + (n - OFF_BRAW) + j] = acc[i][j];
            }
        } else {
            const float* rp = resid + (size_t)m * N + n;
            float* op = outf + (size_t)m * N + n;
#pragma unroll
            for (int j = 0; j < 8; ++j) op[j] = rp[j] + acc[i][j];
        }
    }
}

__global__ void __launch_bounds__(256) k_conv(const bf16* __restrict__ proj, const float* __restrict__ cw, float* __restrict__ act) {
    const size_t idx = (size_t)blockIdx.x * 256 + threadIdx.x;
    const int c = (int)(idx % 3072); const int m = (int)(idx / 3072);
    const int t = m % SEQ;
    float s = 0.f;
#pragma unroll
    for (int j = 0; j < 4; ++j) {
        const int tt = t - 3 + j;
        if (tt >= 0) s += cw[j * 3072 + c] * bf2f(proj[(size_t)(m - 3 + j) * INW + OFF_QKV + c]);
    }
    act[idx] = silu(s);
}

__global__ void __launch_bounds__(256) k_l2(float* __restrict__ act) {
    const int wv = blockIdx.x * 4 + (threadIdx.x >> 6), lane = threadIdx.x & 63;
    const int m = wv >> 4, r = wv & 15;
    float* p = act + (size_t)m * 3072 + r * 128;
    float a = p[lane], b = p[lane + 64];
    float s = a * a + b * b;
    for (int o = 32; o >= 1; o >>= 1) s += __shfl_xor(s, o);
    const float sc = rsqrtf(s + EPS);
    p[lane] = a * sc; p[lane + 64] = b * sc;
}

__global__ void __launch_bounds__(256) k_gates(const float* __restrict__ ab, const float* __restrict__ a_log, const float* __restrict__ dt_bias, float* __restrict__ gates) {
    const int idx = blockIdx.x * 256 + threadIdx.x;
    const int m = idx >> 3, h = idx & 7;
    const float br = ab[(size_t)m * 16 + h], ar = ab[(size_t)m * 16 + 8 + h];
    gates[(size_t)m * 16 + h] = sigmoidf(br);
    gates[(size_t)m * 16 + 8 + h] = -__expf(a_log[h]) * softplus(ar + dt_bias[h]);
}

__global__ void __launch_bounds__(128) k_scan(const float* __restrict__ act, const float* __restrict__ gates, float* __restrict__ oraw) {
    __shared__ float kq[2][256];
    const int b = blockIdx.x >> 3, h = blockIdx.x & 7, e = threadIdx.x;
    float S[128];
#pragma unroll
    for (int d = 0; d < 128; ++d) S[d] = 0.f;
    const float scale = 0.08838834764831845f;
    const size_t m0 = (size_t)b * SEQ;
    float nk = act[m0 * 3072 + 1024 + h * 128 + e], nq = act[m0 * 3072 + h * 128 + e], nv = act[m0 * 3072 + 2048 + h * 128 + e];
    for (int t = 0; t < SEQ; ++t) {
        const size_t m = m0 + t;
        const int buf = t & 1;
        kq[buf][e] = nk; kq[buf][128 + e] = nq;
        const float v = nv;
        const float beta = gates[m * 16 + h], a = __expf(gates[m * 16 + 8 + h]);
        if (t + 1 < SEQ) {
            nk = act[(m + 1) * 3072 + 1024 + h * 128 + e]; nq = act[(m + 1) * 3072 + h * 128 + e]; nv = act[(m + 1) * 3072 + 2048 + h * 128 + e];
        }
        __syncthreads();
        float ks0 = 0.f, ks1 = 0.f, ks2 = 0.f, ks3 = 0.f;
#pragma unroll
        for (int d = 0; d < 128; d += 4) {
            const float4 k4 = *(const float4*)&kq[buf][d];
            ks0 = fmaf(k4.x, S[d], ks0); ks1 = fmaf(k4.y, S[d + 1], ks1); ks2 = fmaf(k4.z, S[d + 2], ks2); ks3 = fmaf(k4.w, S[d + 3], ks3);
        }
        const float kS = (ks0 + ks1) + (ks2 + ks3);
        const float vn = beta * (v - a * kS);
        float o0 = 0.f, o1 = 0.f, o2 = 0.f, o3 = 0.f;
#pragma unroll
        for (int d = 0; d < 128; d += 4) {
            const float4 k4 = *(const float4*)&kq[buf][d];
            const float4 q4 = *(const float4*)&kq[buf][128 + d];
            S[d] = fmaf(a, S[d], k4.x * vn); S[d + 1] = fmaf(a, S[d + 1], k4.y * vn); S[d + 2] = fmaf(a, S[d + 2], k4.z * vn); S[d + 3] = fmaf(a, S[d + 3], k4.w * vn);
            o0 = fmaf(q4.x, S[d], o0); o1 = fmaf(q4.y, S[d + 1], o1); o2 = fmaf(q4.z, S[d + 2], o2); o3 = fmaf(q4.w, S[d + 3], o3);
        }
        oraw[m * 1024 + h * 128 + e] = ((o0 + o1) + (o2 + o3)) * scale;
    }
}

__global__ void __launch_bounds__(256) k_gateA(const float* __restrict__ oraw, const bf16* __restrict__ proj, const float* __restrict__ hw, float* __restrict__ concat) {
    const int wv = blockIdx.x * 4 + (threadIdx.x >> 6), lane = threadIdx.x & 63;
    const int m = wv >> 3, h = wv & 7;
    const float* p = oraw + (size_t)m * 1024 + h * 128;
    const float a = p[lane], b = p[lane + 64];
    float s = a * a + b * b;
    for (int o = 32; o >= 1; o >>= 1) s += __shfl_xor(s, o);
    const float sc = rsqrtf(s / 128.f + EPS);
    const bf16* z = proj + (size_t)m * INW + OFF_ZA + h * 128;
    float* c = concat + (size_t)m * MIXW + h * 128;
    c[lane] = a * sc * hw[lane] * silu(bf2f(z[lane]));
    c[lane + 64] = b * sc * hw[lane + 64] * silu(bf2f(z[lane + 64]));
}

__global__ void __launch_bounds__(256) k_lnB(const bf16* __restrict__ proj, const float* __restrict__ lw, const float* __restrict__ lb, float* __restrict__ vn) {
    __shared__ float red[4];
    const int m = blockIdx.x, tid = threadIdx.x;
    const bf16* p = proj + (size_t)m * INW + OFF_VB;
    float v[4]; float s = 0.f;
#pragma unroll
    for (int j = 0; j < 4; ++j) { v[j] = bf2f(p[tid + 256 * j]); s += v[j]; }
    const float mu = block_sum_256(s, red) / 1024.f;
    float q = 0.f;
#pragma unroll
    for (int j = 0; j < 4; ++j) { v[j] -= mu; q += v[j] * v[j]; }
    const float rs = rsqrtf(block_sum_256(q, red) / 1024.f + EPS);
#pragma unroll
    for (int j = 0; j < 4; ++j) { const int c = tid + 256 * j; vn[(size_t)m * 1024 + c] = v[j] * rs * lw[c] + lb[c]; }
}

__global__ void __launch_bounds__(256) k_sguB(const float* __restrict__ vn, const bf16* __restrict__ proj, const float* __restrict__ ws, const float* __restrict__ bs, float* __restrict__ concat) {
    const size_t idx = (size_t)blockIdx.x * 256 + threadIdx.x;
    const int ch = (int)(idx & 1023); const int m = (int)(idx >> 10);
    const int g = ch >> 7, t = m & 127, mbase = m - t;
    const float* wrow = ws + ((size_t)g * 128 + t) * 128;
    float s = 0.f;
    for (int sp = 0; sp <= t; ++sp) s = fmaf(wrow[sp], vn[(size_t)(mbase + sp) * 1024 + ch], s);
    s += bs[g * 128 + t];
    const float u = bf2f(proj[(size_t)m * INW + OFF_UB + ch]), z = bf2f(proj[(size_t)m * INW + OFF_ZB + ch]);
    concat[(size_t)m * MIXW + 1024 + ch] = u * s * silu(z);
}

__global__ void __launch_bounds__(256) k_final(const float* __restrict__ hbuf, const float* __restrict__ w, float* __restrict__ out) {
    __shared__ float red[4];
    const int m = blockIdx.x, tid = threadIdx.x;
    const float* p = hbuf + (size_t)m * DM;
    float v[8]; float s = 0.f;
#pragma unroll
    for (int j = 0; j < 8; ++j) { v[j] = p[tid + 256 * j]; s += v[j] * v[j]; }
    const float rs = rsqrtf(block_sum_256(s, red) / DM + EPS);
#pragma unroll
    for (int j = 0; j < 8; ++j) { const int c = tid + 256 * j; out[(size_t)m * DM + c] = v[j] * rs * w[c]; }
}
}

extern "C" void kernel_launch(void* const* d_in, const int* in_sizes, int n_in, void* d_out, int out_size, void* d_ws, size_t ws_size, hipStream_t stream) {
    using namespace nv;
    const float* x = (const float*)d_in[0]; const float* norm_w = (const float*)d_in[1]; const float* w_in = (const float*)d_in[2];
    const float* conv_w = (const float*)d_in[3]; const float* a_log = (const float*)d_in[4]; const float* dt_bias = (const float*)d_in[5];
    const float* head_w = (const float*)d_in[6]; const float* ln_w = (const float*)d_in[7]; const float* ln_b = (const float*)d_in[8];
    const float* w_sp = (const float*)d_in[9]; const float* b_sp = (const float*)d_in[10]; const float* w_out = (const float*)d_in[11];
    const float* fin_w = (const float*)d_in[12];
    float* out = (float*)d_out;
    char* ws = (char*)d_ws;
    const size_t MiB = 1u << 20;
    bf16* proj = (bf16*)(ws + 0);
    float* act = (float*)(ws + 232 * MiB);
    float* vn = (float*)(ws + 232 * MiB);
    float* hbuf = (float*)(ws + 232 * MiB);
    float* oraw = (float*)(ws + 424 * MiB);
    float* rstd = (float*)(ws + 488 * MiB);
    float* ab = (float*)(ws + 489 * MiB);
    float* gates = (float*)(ws + 491 * MiB);
    float* concat = out;

    k_rstd<<<M, 256, 0, stream>>>(x, rstd);
    k_gemm<0><<<dim3((INW + 127) / 128, M / 128), 256, 0, stream>>>(x, w_in, INW, DM, rstd, norm_w, proj, ab, nullptr, nullptr);
    k_lnB<<<M, 256, 0, stream>>>(proj, ln_w, ln_b, vn);
    k_sguB<<<(M * 1024) / 256, 256, 0, stream>>>(vn, proj, w_sp, b_sp, concat);
    k_conv<<<(M * 3072) / 256, 256, 0, stream>>>(proj, conv_w, act);
    k_l2<<<(M * 16) / 4, 256, 0, stream>>>(act);
    k_gates<<<(M * 8) / 256, 256, 0, stream>>>(ab, a_log, dt_bias, gates);
    k_scan<<<BATCH * AH, 128, 0, stream>>>(act, gates, oraw);
    k_gateA<<<(M * 8) / 4, 256, 0, stream>>>(oraw, proj, head_w, concat);
    k_gemm<1><<<dim3(DM / 128, M / 128), 256, 0, stream>>>(concat, w_out, DM, MIXW, nullptr, nullptr, nullptr, nullptr, x, hbuf);
    k_final<<<M, 256, 0, stream>>>(hbuf, fin_w, out);
}
```

```cpp
#include <hip/hip_runtime.h>
#include <cstdio>
#include <cstdint>
namespace pg8 {
#define PG8_LAS __attribute__((address_space(3)))
typedef unsigned short bf16_t;
typedef short bf16x8 __attribute__((ext_vector_type(8)));
typedef float f32x4 __attribute__((ext_vector_type(4)));
typedef unsigned u32x4 __attribute__((ext_vector_type(4)));
constexpr int BM = 256, BK = 64, HALF = 128, HTB = HALF * BK * 2  , STAGE_BYTES = 8 * HTB, NXCD = 8, WGM = 8;

__host__ __device__ __forceinline__ int lds_byte(int r, int c) { const int st = (r >> 4) * 2 + (c >> 5), rr = r & 15, cc = c & 31, ob = rr * 64 + cc * 2; return st * 1024 + (ob ^ (((ob >> 9) & 1) << 5)); }
__host__ __device__ __forceinline__ void stage_rc(int b, int& R, int& C) { const int st = b / 1024, sb = b % 1024, swz = sb ^ (((sb >> 9) & 1) << 5); R = (st >> 1) * 16 + swz / 64; C = (st & 1) * 32 + (swz % 64) / 2; }
__host__ __device__ __forceinline__ int perm32(int rho) { const int n = rho >> 4, i = rho & 15; return 8 * (i >> 2) + 4 * n + (i & 3); }

struct Unit { int pm, pn; };
struct Gemm { const bf16_t* A; const bf16_t* Bt; int M, N, K; };

struct StaticOrder {
    int nM, nN, nwg, G, c;
    __host__ __device__ void init(int M, int N, int G_, int c_) { nM = M / BM; nN = N / BM; nwg = nM * nN; G = G_; c = c_; }
    __host__ __device__ bool next(int i, Unit& u) const {
        const long L = (long)i * G + c; if (L >= nwg) return false;
        int wgid = (int)L; { const int q = nwg / NXCD, r = nwg % NXCD, xcd = wgid % NXCD, off = wgid / NXCD; wgid = (xcd < r ? xcd * (q + 1) : r * (q + 1) + (xcd - r) * q) + off; }
        const int nig = WGM * nN, gid = wgid / nig, fm = gid * WGM, gsz = (nM - fm) < WGM ? (nM - fm) : WGM;
        u.pm = fm + ((wgid % nig) % gsz); u.pn = (wgid % nig) / gsz; return true;
    }
    __device__ __forceinline__ void a_ready(const Unit&) const {}
    __device__ __forceinline__ void done(const Unit&) const {}
};


__device__ __forceinline__ unsigned cvt_pk_bf16(float lo, float hi) { unsigned r; asm volatile("v_cvt_pk_bf16_f32 %0, %1, %2" : "=v"(r) : "v"(lo), "v"(hi)); return r; }
struct EpiBf16 {
    static constexpr bool PERM = true, AFTER_DRAIN = false;
    bf16_t* O; int ldc;
    __device__ __forceinline__ void operator()(const f32x4 (&acc)[2][2][4][2], const Unit& u, int wr, int wc, int fr, int fq) const {
        const int row0 = u.pm * BM + wr * 64 + fr; const int col0 = u.pn * BM + wc * 32 + 8 * fq;
#pragma unroll
        for (int ai = 0; ai < 2; ++ai)
#pragma unroll
            for (int m = 0; m < 4; ++m) { bf16_t* rowp = O + (size_t)(row0 + ai * HALF + m * 16) * ldc + col0;
#pragma unroll
                for (int bj = 0; bj < 2; ++bj) { const f32x4 v0 = acc[ai][bj][m][0], v1 = acc[ai][bj][m][1];
                    u32x4 w; w.x = cvt_pk_bf16(v0[0], v0[1]); w.y = cvt_pk_bf16(v0[2], v0[3]); w.z = cvt_pk_bf16(v1[0], v1[1]); w.w = cvt_pk_bf16(v1[2], v1[3]);
                    *(u32x4*)(rowp + bj * HALF) = w; } }
    }
};
struct EpiResid {
    static constexpr bool PERM = false, AFTER_DRAIN = false;
    const float* base; float* out; int ldc; float* rowss;
    __device__ __forceinline__ void operator()(const f32x4 (&acc)[2][2][4][2], const Unit& u, int wr, int wc, int fr, int fq) const {
        const int row0 = u.pm * BM + wr * 64 + fr, col0 = u.pn * BM + wc * 32 + 4 * fq;
#pragma unroll
        for (int ai = 0; ai < 2; ++ai)
#pragma unroll
            for (int m = 0; m < 4; ++m) { const int row = row0 + ai * HALF + m * 16; const size_t off = (size_t)row * ldc + col0; float ss = 0.f;
#pragma unroll
                for (int bj = 0; bj < 2; ++bj)
#pragma unroll
                    for (int n = 0; n < 2; ++n) { const f32x4 b = *(const f32x4*)(base + off + bj * HALF + n * 16); const f32x4 o = b + acc[ai][bj][m][n];
                        *(f32x4*)(out + off + bj * HALF + n * 16) = o; ss += (o[0] * o[0] + o[1] * o[1]) + (o[2] * o[2] + o[3] * o[3]); }
                ss += __shfl_xor(ss, 16); ss += __shfl_xor(ss, 32);
                if (fq == 0) rowss[(size_t)row * 32 + u.pn * 4 + wc] = ss; }
    }
};

template <class Epi, class Sched, bool ALIGN_EPI = false, bool SP2 = false>
__device__ __forceinline__ void gemm_phase(PG8_LAS unsigned char* lds, const Gemm g, const Sched& S, const Epi& E) {
    const int tid = threadIdx.x, wid = __builtin_amdgcn_readfirstlane(tid >> 6), lane = tid & 63, wr = wid >> 2, wc = wid & 3, fr = lane & 15, fq = lane >> 4;
    const int K = g.K, nt = K / BK;
    unsigned voffA[2], voffB[2];
#pragma unroll
    for (int i = 0; i < 2; ++i) { int R, C; stage_rc(tid * 16 + i * 8192, R, C); const int Rb = Epi::PERM ? ((R & ~31) + perm32(R & 31)) : R;
        voffA[i] = (unsigned)(R * K + C) * 2u; voffB[i] = (unsigned)(Rb * K + C) * 2u; }
    const size_t kstep = (size_t)(BK * 2);
    const size_t hstep = (size_t)HALF * K * 2;
    const size_t tstep = 2 * hstep;
    const unsigned ldsw = (unsigned)wid * 1024u;
    const int aoff = lds_byte(wr * 64 + fr, fq * 8), boff = lds_byte(wc * 32 + fr, fq * 8);
#define PG8_SA(b, h) (((b) * 2 + (h)) * HTB)
#define PG8_SB(b, h) ((4 + (b) * 2 + (h)) * HTB)
#define PG8_STAGE(bufoff, gbase, voff) do { _Pragma("unroll") for (int _i = 0; _i < 2; ++_i) \
        __builtin_amdgcn_global_load_lds((const unsigned*)((const char*)(gbase) + (voff)[_i]), (PG8_LAS unsigned*)(lds + (bufoff) + ldsw + _i * 8192), 16, 0, 0); } while (0)
#define PG8_LDA(dst, b, h) do { _Pragma("unroll") for (int m = 0; m < 4; ++m) _Pragma("unroll") for (int k = 0; k < 2; ++k) dst[m][k] = *(const PG8_LAS bf16x8*)(lds + PG8_SA(b, h) + aoff + m * 2048 + k * 1024); } while (0)
#define PG8_LDB(dst, b, h) do { _Pragma("unroll") for (int n = 0; n < 2; ++n) _Pragma("unroll") for (int k = 0; k < 2; ++k) dst[n][k] = *(const PG8_LAS bf16x8*)(lds + PG8_SB(b, h) + boff + n * 2048 + k * 1024); } while (0)
#define PG8_MMA(ai, bj, At, Bt) do { __builtin_amdgcn_s_setprio(1); _Pragma("unroll") for (int m = 0; m < 4; ++m) _Pragma("unroll") for (int n = 0; n < 2; ++n) _Pragma("unroll") for (int k = 0; k < 2; ++k) \
        acc[ai][bj][m][n] = __builtin_amdgcn_mfma_f32_16x16x32_bf16(Bt[n][k], At[m][k], acc[ai][bj][m][n], 0, 0, 0); __builtin_amdgcn_s_setprio(0); } while (0)
#define PG8_WAIT_V(n) asm volatile("s_waitcnt vmcnt(" #n ")" ::: "memory")
#define PG8_WAIT_L(n) asm volatile("s_waitcnt lgkmcnt(" #n ")" ::: "memory")
#define PG8_BAR __builtin_amdgcn_s_barrier()
#define PG8_SCHED __builtin_amdgcn_sched_barrier(0)
    Unit cur, nxt; int ui = 0;
    if (!S.next(0, cur)) return;
    f32x4 acc[2][2][4][2];
#pragma unroll
    for (int a = 0; a < 2; ++a)
#pragma unroll
        for (int b = 0; b < 2; ++b)
#pragma unroll
            for (int m = 0; m < 4; ++m)
#pragma unroll
                for (int n = 0; n < 2; ++n) acc[a][b][m][n] = (f32x4){0.f, 0.f, 0.f, 0.f};
    bf16x8 At[4][2], B0[2][2], B1[2][2];
    const char* cA = (const char*)g.A + (size_t)cur.pm * tstep; const char* cB = (const char*)g.Bt + (size_t)cur.pn * tstep;
    S.a_ready(cur);
    if constexpr (SP2) {
        PG8_STAGE(PG8_SB(0, 0), cB, voffB); PG8_STAGE(PG8_SB(0, 1), cB + hstep, voffB); PG8_STAGE(PG8_SA(0, 0), cA, voffA); PG8_STAGE(PG8_SA(0, 1), cA + hstep, voffA);
        if (wr == 1) PG8_BAR;
        PG8_WAIT_V(2); PG8_BAR;
        PG8_STAGE(PG8_SB(1, 0), cB + kstep, voffB); PG8_STAGE(PG8_SA(1, 0), cA + kstep, voffA); PG8_STAGE(PG8_SB(1, 1), cB + hstep + kstep, voffB);
        PG8_WAIT_V(6); PG8_BAR;
    } else {
        PG8_STAGE(PG8_SB(0, 0), cB, voffB); PG8_STAGE(PG8_SA(0, 0), cA, voffA); PG8_STAGE(PG8_SB(0, 1), cB + hstep, voffB); PG8_STAGE(PG8_SA(0, 1), cA + hstep, voffA);
        if (wr == 1) PG8_BAR;
        PG8_WAIT_V(4); PG8_BAR;
        PG8_STAGE(PG8_SB(1, 0), cB + kstep, voffB); PG8_STAGE(PG8_SA(1, 0), cA + kstep, voffA); PG8_STAGE(PG8_SB(1, 1), cB + hstep + kstep, voffB);
        PG8_WAIT_V(6); PG8_BAR;
    }
    for (;;) {
        const bool has_next = S.next(ui + 1, nxt);
        const char* nA = has_next ? (const char*)g.A + (size_t)nxt.pm * tstep : cA; const char* nB = has_next ? (const char*)g.Bt + (size_t)nxt.pn * tstep : cB;
        for (int t = 0; t < nt; t += 2) {
            const bool last = (t == nt - 2);
            const char* a1 = cA + (size_t)(t + 1) * kstep;
            const char* a2 = last ? nA : cA + (size_t)(t + 2) * kstep; const char* b2 = last ? nB : cB + (size_t)(t + 2) * kstep;
            const char* a3 = a2 + kstep; const char* b3 = b2 + kstep;
            if (last && has_next) S.a_ready(nxt);
            if constexpr (SP2) {
            PG8_LDB(B0, 0, 0); PG8_LDB(B1, 0, 1); PG8_SCHED; PG8_LDA(At, 0, 0); PG8_STAGE(PG8_SA(1, 1), a1 + hstep, voffA);
            PG8_WAIT_V(8); PG8_WAIT_L(0); PG8_BAR; PG8_MMA(0, 0, At, B0); PG8_MMA(0, 1, At, B1); PG8_BAR; PG8_SCHED;
            PG8_LDA(At, 0, 1); PG8_STAGE(PG8_SB(0, 0), b2, voffB); PG8_STAGE(PG8_SB(0, 1), b2 + hstep, voffB); PG8_STAGE(PG8_SA(0, 0), a2, voffA);
            PG8_WAIT_V(8); PG8_WAIT_L(0); PG8_BAR; PG8_MMA(1, 0, At, B0); PG8_MMA(1, 1, At, B1); PG8_BAR; PG8_SCHED;
            PG8_LDB(B0, 1, 0); PG8_LDB(B1, 1, 1); PG8_SCHED; PG8_LDA(At, 1, 0); PG8_STAGE(PG8_SA(0, 1), a2 + hstep, voffA);
            PG8_WAIT_V(8); PG8_WAIT_L(0); PG8_BAR; PG8_MMA(0, 0, At, B0); PG8_MMA(0, 1, At, B1); PG8_BAR; PG8_SCHED;
            PG8_LDA(At, 1, 1); PG8_STAGE(PG8_SB(1, 0), b3, voffB); PG8_STAGE(PG8_SB(1, 1), b3 + hstep, voffB); PG8_STAGE(PG8_SA(1, 0), a3, voffA);
            PG8_WAIT_V(8); PG8_WAIT_L(0); PG8_BAR; PG8_MMA(1, 0, At, B0); PG8_MMA(1, 1, At, B1); PG8_BAR; PG8_SCHED;
            } else {
            PG8_LDB(B0, 0, 0); PG8_SCHED; PG8_LDA(At, 0, 0); PG8_STAGE(PG8_SA(1, 1), a1 + hstep, voffA);
            PG8_WAIT_L(8); PG8_BAR; PG8_WAIT_L(0); PG8_MMA(0, 0, At, B0); PG8_BAR; PG8_SCHED;
            PG8_LDB(B1, 0, 1); PG8_STAGE(PG8_SB(0, 0), b2, voffB);
            PG8_BAR; PG8_WAIT_L(0); PG8_MMA(0, 1, At, B1); PG8_BAR;
            PG8_LDA(At, 0, 1); PG8_STAGE(PG8_SA(0, 0), a2, voffA);
            PG8_BAR; PG8_WAIT_L(0); PG8_MMA(1, 0, At, B0); PG8_BAR; PG8_SCHED;
            PG8_STAGE(PG8_SB(0, 1), b2 + hstep, voffB);
            PG8_WAIT_V(6); PG8_BAR; PG8_MMA(1, 1, At, B1); PG8_BAR;
            PG8_LDB(B0, 1, 0); PG8_SCHED; PG8_LDA(At, 1, 0); PG8_STAGE(PG8_SA(0, 1), a2 + hstep, voffA);
            PG8_WAIT_L(8); PG8_BAR; PG8_WAIT_L(0); PG8_MMA(0, 0, At, B0); PG8_BAR; PG8_SCHED;
            PG8_LDB(B1, 1, 1); PG8_STAGE(PG8_SB(1, 0), b3, voffB);
            PG8_BAR; PG8_WAIT_L(0); PG8_MMA(0, 1, At, B1); PG8_BAR;
            PG8_LDA(At, 1, 1); PG8_STAGE(PG8_SA(1, 0), a3, voffA);
            PG8_BAR; PG8_WAIT_L(0); PG8_MMA(1, 0, At, B0); PG8_BAR; PG8_SCHED;
            PG8_STAGE(PG8_SB(1, 1), b3 + hstep, voffB);
            PG8_WAIT_V(6); PG8_BAR; PG8_MMA(1, 1, At, B1); PG8_BAR;
            }
        }
        if constexpr (ALIGN_EPI) { if (wr == 0) PG8_BAR; }
        if constexpr (!Epi::AFTER_DRAIN) { E(acc, cur, wr, wc, fr, fq); S.done(cur); }
        if (!has_next) break;
#pragma unroll
        for (int a = 0; a < 2; ++a)
#pragma unroll
            for (int b = 0; b < 2; ++b)
#pragma unroll
                for (int m = 0; m < 4; ++m)
#pragma unroll
                    for (int n = 0; n < 2; ++n) acc[a][b][m][n] = (f32x4){0.f, 0.f, 0.f, 0.f};
        cur = nxt; cA = nA; cB = nB; ++ui;
        if constexpr (ALIGN_EPI) { if (wr == 1) PG8_BAR; }
    }
    PG8_WAIT_V(0);
    if constexpr (!ALIGN_EPI) { if (wr == 0) PG8_BAR; }
    PG8_BAR;
    if constexpr (Epi::AFTER_DRAIN) { E.fused(acc, cur, wr, wc, fr, fq, lds, wid, lane); S.done(cur); }
#undef PG8_SA
#undef PG8_SB
#undef PG8_STAGE
#undef PG8_LDA
#undef PG8_LDB
#undef PG8_MMA
#undef PG8_WAIT_V
#undef PG8_WAIT_L
#undef PG8_BAR
#undef PG8_SCHED
}
}

constexpr int NWAVES = 8;
constexpr int BATCH = 4, SEQ = 4096, DM = 2048, M = BATCH * SEQ;
constexpr int AH = 8, INW = 7184, PW = 7168, MIXW = 2048;
constexpr int PC_ZA = 3072, PC_UB = 4096, PC_VB = 5120, PC_ZB = 6144;
constexpr float EPS = 1e-6f;
constexpr size_t MiB = 1u << 20;
constexpr size_t WS_CTL = 0, CTL_ZERO_BYTES = 1 * MiB;
constexpr size_t WS_WT1 = 2 * MiB;
constexpr size_t WS_WT2 = 30 * MiB;
constexpr size_t WS_XN = 40 * MiB;
constexpr size_t WS_ORAW = 40 * MiB;
constexpr size_t WS_PROJ = 104 * MiB;
constexpr size_t WS_CONCAT = 328 * MiB;
constexpr size_t WS_AB = 392 * MiB, WS_GATES = 393 * MiB, WS_LNST = 394 * MiB, WS_ROWSS = 395 * MiB;
constexpr size_t WS_ACT = 400 * MiB;
constexpr int CW_BAR = 4096;
constexpr int RING_OFF = 0, RING_BYTES = 131072;
constexpr int LDSCTL_OFF = RING_BYTES, MISC_OFF = LDSCTL_OFF + 320;
constexpr int LDS_BYTES = 147456;

#define GAS __attribute__((address_space(1)))
#define LAS __attribute__((address_space(3)))
typedef unsigned short bf16;
typedef unsigned v4u __attribute__((ext_vector_type(4)));
typedef unsigned v2u __attribute__((ext_vector_type(2)));
typedef float f32x4 __attribute__((ext_vector_type(4)));
typedef GAS unsigned gu32;
#define RLX_AGENT __ATOMIC_RELAXED, __HIP_MEMORY_SCOPE_AGENT
#define LDS_WAIT() asm volatile("s_waitcnt lgkmcnt(0)" ::: "memory")
#define VM_WAIT() asm volatile("s_waitcnt vmcnt(0)" ::: "memory")
__device__ __forceinline__ unsigned f2bf(float f) { unsigned u = __builtin_bit_cast(unsigned, f); return (u + 0x7fffu + ((u >> 16) & 1u)) >> 16; }
__device__ __forceinline__ unsigned pk2(float lo, float hi) { return f2bf(lo) | (f2bf(hi) << 16); }
__device__ __forceinline__ float bf2f(unsigned b) { return __uint_as_float(b << 16); }
__device__ __forceinline__ float bflo(unsigned w) { return __uint_as_float(w << 16); }
__device__ __forceinline__ float bfhi(unsigned w) { return __uint_as_float(w & 0xffff0000u); }
__device__ __forceinline__ float silu(float x) { return x / (1.f + __expf(-x)); }
__device__ __forceinline__ float sigmoidf_(float x) { return 1.f / (1.f + __expf(-x)); }
__device__ __forceinline__ float softplus_(float x) { return fmaxf(x, 0.f) + log1pf(__expf(-fabsf(x))); }
__device__ __forceinline__ float wave_sum(float v) {
#pragma unroll
    for (int o = 1; o < 64; o <<= 1) v += __shfl_xor(v, o);
    return v;
}

#define XB_TMO      128
#define XB_XCNT(j)  (256  + 64 * (j))
#define XB_XSUB(j)  (1280 + 64 * (j))
#define XB_XGEN(j)  (2304 + 64 * (j))
#define XB_TOP      3328
#define XB_TOPGEN   3392
#define XCD_BAR_WORDS 3456
#define XB_SPIN_CAP (1u << 18)

__device__ __forceinline__ unsigned xb_ld(unsigned* p)              { return __hip_atomic_load(p, __ATOMIC_RELAXED, __HIP_MEMORY_SCOPE_AGENT); }
__device__ __forceinline__ unsigned xb_add(unsigned* p, unsigned v) { return __hip_atomic_fetch_add(p, v, __ATOMIC_RELAXED, __HIP_MEMORY_SCOPE_AGENT); }
__device__ __forceinline__ unsigned xb_xcc_id() { return (unsigned)__builtin_amdgcn_s_getreg((3 << 11) | 20) & 0xFu; }
#define XB_SPIN(cond, bar) do { unsigned _sp = 0; while (cond) { __builtin_amdgcn_s_sleep(1); \
    if ((++_sp & 255u) == 0u) { if (xb_ld(&(bar)[XB_TMO])) break; if (_sp > XB_SPIN_CAP) { atomicAdd(&(bar)[XB_TMO], 1u); break; } } } } while (0)

struct XcdBarrier {
    unsigned* bar; unsigned x;
    volatile LAS unsigned* st;
};

__device__ __forceinline__ XcdBarrier xcd_barrier_post(unsigned* bar, volatile LAS unsigned* st) {
    XcdBarrier b; b.bar = bar; b.x = xb_xcc_id(); b.st = st;
    if (threadIdx.x == 0) (void)xb_add(&bar[XB_XCNT(b.x)], 1u);
    return b;
}
__device__ __forceinline__ void xcd_barrier_complete(unsigned* bar, unsigned x, unsigned& nloc, unsigned& nx) {
    const unsigned G = gridDim.x * gridDim.y * gridDim.z;
    unsigned sum, cnt, mine, sp = 0u;
    for (;;) {
        sum = 0u; cnt = 0u; mine = 0u;
#pragma unroll
        for (unsigned j = 0; j < 16; ++j) { const unsigned c = xb_ld(&bar[XB_XCNT(j)]); sum += c; cnt += (c > 0u) ? 1u : 0u; mine = (j == x) ? c : mine; }
        if (sum == G) break;
        __builtin_amdgcn_s_sleep(1);
        if ((++sp & 255u) == 0u) { if (xb_ld(&bar[XB_TMO])) break; if (sp > XB_SPIN_CAP) { atomicAdd(&bar[XB_TMO], 1u); break; } }
    }
    nloc = mine > 0u ? mine : 1u; nx = cnt > 0u ? cnt : 1u;
}

__device__ __forceinline__ void xcd_barrier(const XcdBarrier& b) {
    asm volatile("s_waitcnt vmcnt(0)" ::: "memory");
    __syncthreads();
    if (threadIdx.x == 0) {
        unsigned* bar = b.bar;
        __builtin_amdgcn_s_waitcnt(0);
        unsigned nloc = b.st[0], nx = b.st[1];
        if (nloc == 0u) { xcd_barrier_complete(bar, b.x, nloc, nx); b.st[0] = nloc; b.st[1] = nx; }
        const unsigned old = xb_add(&bar[XB_XSUB(b.x)], 1u);
        const unsigned gen = old / nloc;
        if (old + 1u == (gen + 1u) * nloc) {
            __builtin_amdgcn_fence(__ATOMIC_RELEASE, "agent");
            asm volatile("s_waitcnt vmcnt(0)" ::: "memory");
            const unsigned og = xb_add(&bar[XB_TOP], 1u);
            const unsigned tg = og / nx;
            if (og + 1u == (tg + 1u) * nx) xb_add(&bar[XB_TOPGEN], 1u);
            else XB_SPIN(xb_ld(&bar[XB_TOPGEN]) == tg, bar);
            __builtin_amdgcn_fence(__ATOMIC_ACQUIRE, "agent");
            xb_add(&bar[XB_XGEN(b.x)], 1u);
            asm volatile("s_waitcnt vmcnt(0)" ::: "memory");
        } else {
            XB_SPIN(xb_ld(&bar[XB_XGEN(b.x)]) == gen, bar);
            __builtin_amdgcn_fence(__ATOMIC_ACQUIRE, "agent");
            asm volatile("s_waitcnt vmcnt(0)" ::: "memory");
        }
    }
    __syncthreads();
}


struct Frame {
    unsigned char* lds;
    int tid, lane, wave, vcu, G;
    const float *x, *norm_w, *w_in, *conv_w, *a_log, *dt_bias, *head_w, *ln_w, *ln_b, *w_sp, *b_sp, *w_out, *fin_w;
    float* out;
    bf16 *Wt1, *Wt2, *XN, *proj, *concat, *act;
    float *ab, *gates, *lnst, *rowss, *oraw;
};

__device__ __forceinline__ void p0_transpose_item(const float* W, int srcN, int src_n0, int k0, bf16* WT, int K, int dst_row0, LAS float* scr, int lane) {
#pragma unroll 8
    for (int i = 0; i < 32; ++i) { const int kk = 2 * i + (lane >> 5); scr[kk * 33 + (lane & 31)] = W[(size_t)(k0 + kk) * srcN + src_n0 + (lane & 31)]; }
    LDS_WAIT(); asm volatile("" ::: "memory");
    const int c = lane & 7;
#pragma unroll
    for (int j = 0; j < 4; ++j) { const int n = (lane >> 3) + 8 * j; const LAS float* s = scr + (8 * c) * 33 + n;
        v4u o; o.x = pk2(s[0 * 33], s[1 * 33]); o.y = pk2(s[2 * 33], s[3 * 33]); o.z = pk2(s[4 * 33], s[5 * 33]); o.w = pk2(s[6 * 33], s[7 * 33]);
        *(GAS v4u*)(WT + (size_t)(dst_row0 + n) * K + k0 + 8 * c) = o; }
    LDS_WAIT(); asm volatile("" ::: "memory");
}
__device__ __forceinline__ void p0_prologue(Frame& F) {
    LAS float* scr = (LAS float*)((LAS unsigned char*)F.lds + RING_OFF + F.wave * 16384);
    const int gw = F.vcu * NWAVES + F.wave, NGW = F.G * NWAVES;
    constexpr int I_1 = (DM / 64) * (PW / 32), I_2 = (MIXW / 64) * (DM / 32);
    for (int it = gw; it < I_1 + I_2; it += NGW) {
        if (it < I_1) { const int kb = it / (PW / 32), nb = it % (PW / 32), n0 = 32 * nb;
            p0_transpose_item(F.w_in, INW, n0 + (n0 >= 4096 ? 16 : 0), 64 * kb, F.Wt1, DM, n0, scr, F.lane); }
        else { const int r = it - I_1, kb = r / (DM / 32), nb = r % (DM / 32);
            p0_transpose_item(F.w_out, DM, 32 * nb, 64 * kb, F.Wt2, MIXW, 32 * nb, scr, F.lane); }
    }
    __syncthreads();
    LAS float* Wl = (LAS float*)((LAS unsigned char*)F.lds + RING_OFF);
    for (int idx = F.tid; idx < 16 * DM; idx += NWAVES * 64) { const int k = idx >> 4, c = idx & 15; Wl[c * DM + k] = F.w_in[(size_t)k * INW + 4096 + c] * F.norm_w[k]; }
    __syncthreads();
    for (int mp = gw; mp < M / 2; mp += NGW) {
        const int m0 = 2 * mp;
        const GAS f32x4* x0 = (const GAS f32x4*)(F.x + (size_t)m0 * DM) + F.lane;
        const GAS f32x4* x1 = (const GAS f32x4*)(F.x + (size_t)(m0 + 1) * DM) + F.lane;
        f32x4 v0[8], v1[8]; float s0 = 0.f, s1 = 0.f;
#pragma unroll
        for (int j = 0; j < 8; ++j) { v0[j] = x0[64 * j]; v1[j] = x1[64 * j]; }
#pragma unroll
        for (int j = 0; j < 8; ++j) { s0 += (v0[j].x * v0[j].x + v0[j].y * v0[j].y) + (v0[j].z * v0[j].z + v0[j].w * v0[j].w);
                                      s1 += (v1[j].x * v1[j].x + v1[j].y * v1[j].y) + (v1[j].z * v1[j].z + v1[j].w * v1[j].w); }
        const float r0 = rsqrtf(wave_sum(s0) * (1.f / DM) + EPS), r1 = rsqrtf(wave_sum(s1) * (1.f / DM) + EPS);
        float acc[32];
#pragma unroll
        for (int i = 0; i < 32; ++i) acc[i] = 0.f;
#pragma unroll
        for (int j = 0; j < 8; ++j)
#pragma unroll
            for (int c = 0; c < 16; ++c) { const f32x4 w = *(const LAS f32x4*)(Wl + c * DM + 256 * j + 4 * F.lane);
                acc[c] += (v0[j].x * w.x + v0[j].y * w.y) + (v0[j].z * w.z + v0[j].w * w.w);
                acc[16 + c] += (v1[j].x * w.x + v1[j].y * w.y) + (v1[j].z * w.z + v1[j].w * w.w);
                if ((c & 7) == 7) asm volatile("" ::: "memory"); }
#pragma unroll
        for (int i = 0; i < 16; ++i) { const bool up = F.lane & 32; const float send = up ? acc[i] : acc[i + 16], keep = up ? acc[i + 16] : acc[i]; acc[i] = keep + __shfl_xor(send, 32); }
#pragma unroll
        for (int i = 0; i < 8; ++i) { const bool up = F.lane & 16; const float send = up ? acc[i] : acc[i + 8], keep = up ? acc[i + 8] : acc[i]; acc[i] = keep + __shfl_xor(send, 16); }
#pragma unroll
        for (int i = 0; i < 4; ++i) { const bool up = F.lane & 8; const float send = up ? acc[i] : acc[i + 4], keep = up ? acc[i + 4] : acc[i]; acc[i] = keep + __shfl_xor(send, 8); }
#pragma unroll
        for (int i = 0; i < 2; ++i) { const bool up = F.lane & 4; const float send = up ? acc[i] : acc[i + 2], keep = up ? acc[i + 2] : acc[i]; acc[i] = keep + __shfl_xor(send, 4); }
        { const bool up = F.lane & 2; const float send = up ? acc[0] : acc[1], keep = up ? acc[1] : acc[0]; acc[0] = keep + __shfl_xor(send, 2); }
        acc[0] += __shfl_xor(acc[0], 1);
        if ((F.lane & 1) == 0) { const int i = F.lane >> 1; const int r = i >> 4, c = i & 15; F.ab[(size_t)(m0 + r) * 16 + c] = acc[0] * (r ? r1 : r0); }
        GAS unsigned long long* o0 = (GAS unsigned long long*)(F.XN + (size_t)m0 * DM) + F.lane;
        GAS unsigned long long* o1 = (GAS unsigned long long*)(F.XN + (size_t)(m0 + 1) * DM) + F.lane;
#pragma unroll
        for (int j = 0; j < 8; ++j) { const f32x4 nw = ((const GAS f32x4*)F.norm_w)[64 * j + F.lane];
            o0[64 * j] = (unsigned long long)pk2(v0[j].x * r0 * nw.x, v0[j].y * r0 * nw.y) | ((unsigned long long)pk2(v0[j].z * r0 * nw.z, v0[j].w * r0 * nw.w) << 32);
            o1[64 * j] = (unsigned long long)pk2(v1[j].x * r1 * nw.x, v1[j].y * r1 * nw.y) | ((unsigned long long)pk2(v1[j].z * r1 * nw.z, v1[j].w * r1 * nw.w) << 32); }
    }
}

__device__ __forceinline__ void naive_p2(Frame& F) {
    const int gw = F.vcu * NWAVES + F.wave, NGW = F.G * NWAVES, lane = F.lane;
    for (int m = gw; m < M; m += NGW) {
        const v4u* p = (const v4u*)(F.proj + (size_t)m * PW + PC_VB + 16 * lane);
        const v4u a = p[0], b = p[1]; const unsigned w[8] = {a.x, a.y, a.z, a.w, b.x, b.y, b.z, b.w};
        float v[16]; float s = 0.f;
#pragma unroll
        for (int i = 0; i < 8; ++i) { v[2 * i] = bflo(w[i]); v[2 * i + 1] = bfhi(w[i]); s += v[2 * i] + v[2 * i + 1]; }
        const float mu = wave_sum(s) * (1.f / 1024.f); float q = 0.f;
#pragma unroll
        for (int i = 0; i < 16; ++i) { const float d = v[i] - mu; q += d * d; }
        const float rs = rsqrtf(wave_sum(q) * (1.f / 1024.f) + EPS);
        if (lane == 0) { F.lnst[2 * m] = mu; F.lnst[2 * m + 1] = rs; }
    }
    for (int it = gw; it < M * 24; it += NGW) {
        const int m = it / 24, r = it % 24, t = m % SEQ, c = r * 128 + 2 * lane;
        float s0 = 0.f, s1 = 0.f;
#pragma unroll
        for (int j = 0; j < 4; ++j) { if (t - 3 + j >= 0) { const unsigned w = *(const unsigned*)(F.proj + (size_t)(m - 3 + j) * PW + c);
            s0 += F.conv_w[j * 3072 + c] * bflo(w); s1 += F.conv_w[j * 3072 + c + 1] * bfhi(w); } }
        s0 = silu(s0); s1 = silu(s1);
        if (r < 16) { const float sc = rsqrtf(wave_sum(s0 * s0 + s1 * s1) + EPS); s0 *= sc; s1 *= sc; }
        *(unsigned*)(F.act + (size_t)m * 3072 + c) = pk2(s0, s1);
    }
    for (int idx = (F.vcu * NWAVES * 64) + F.tid; idx < M * 8; idx += F.G * NWAVES * 64) {
        const int m = idx >> 3, h = idx & 7;
        F.gates[(size_t)m * 16 + h] = sigmoidf_(F.ab[(size_t)m * 16 + h]);
        F.gates[(size_t)m * 16 + 8 + h] = -__expf(F.a_log[h]) * softplus_(F.ab[(size_t)m * 16 + 8 + h] + F.dt_bias[h]);
    }
}
__device__ __forceinline__ void naive_scan(Frame& F, int b, int h) {
    float* kq = (float*)(F.lds + RING_OFF);
    const int tid = F.tid, e = (tid >> 1) & 127, half = tid & 1;
    float S[64];
#pragma unroll
    for (int d = 0; d < 64; ++d) S[d] = 0.f;
    const size_t m0 = (size_t)b * SEQ;
    const int ldcol = (tid < 128) ? (1024 + h * 128 + tid) : (h * 128 + ((tid - 128) & 127));
    float nkq = bf2f(F.act[m0 * 3072 + ldcol]), nv = bf2f(F.act[m0 * 3072 + 2048 + h * 128 + e]);
    for (int t = 0; t < SEQ; ++t) {
        const size_t m = m0 + t; const int buf = t & 1;
        if (tid < 256) kq[buf * 256 + tid] = nkq;
        const float v = nv;
        if (t + 1 < SEQ) { nkq = bf2f(F.act[(m + 1) * 3072 + ldcol]); nv = bf2f(F.act[(m + 1) * 3072 + 2048 + h * 128 + e]); }
        __syncthreads();
        if (tid < 256) {
            const float beta = F.gates[m * 16 + h], a = __expf(F.gates[m * 16 + 8 + h]);
            const float* kk = kq + buf * 256 + half * 64; const float* qq = kq + buf * 256 + 128 + half * 64;
            float k0 = 0.f, k1 = 0.f, k2 = 0.f, k3 = 0.f;
#pragma unroll
            for (int d = 0; d < 64; d += 4) { const float4 k4 = *(const float4*)(kk + d);
                k0 = fmaf(k4.x, S[d], k0); k1 = fmaf(k4.y, S[d + 1], k1); k2 = fmaf(k4.z, S[d + 2], k2); k3 = fmaf(k4.w, S[d + 3], k3); }
            float kS = (k0 + k1) + (k2 + k3); kS += __shfl_xor(kS, 1);
            const float vn = beta * (v - a * kS);
            float o0 = 0.f, o1 = 0.f, o2 = 0.f, o3 = 0.f;
#pragma unroll
            for (int d = 0; d < 64; d += 4) { const float4 k4 = *(const float4*)(kk + d); const float4 q4 = *(const float4*)(qq + d);
                S[d] = fmaf(a, S[d], k4.x * vn); S[d + 1] = fmaf(a, S[d + 1], k4.y * vn); S[d + 2] = fmaf(a, S[d + 2], k4.z * vn); S[d + 3] = fmaf(a, S[d + 3], k4.w * vn);
                o0 = fmaf(q4.x, S[d], o0); o1 = fmaf(q4.y, S[d + 1], o1); o2 = fmaf(q4.z, S[d + 2], o2); o3 = fmaf(q4.w, S[d + 3], o3); }
            float o = (o0 + o1) + (o2 + o3); o += __shfl_xor(o, 1);
            if (half == 0) F.oraw[m * 1024 + h * 128 + e] = o * 0.08838834764831845f;
        }
    }
}
__device__ __forceinline__ void naive_sgu(Frame& F, int first_block) {
    const size_t nthr = (size_t)(F.G - first_block) * NWAVES * 64;
    for (size_t idx = (size_t)(blockIdx.x - first_block) * NWAVES * 64 + F.tid; idx < (size_t)M * 1024; idx += nthr) {
        const int ch = (int)(idx & 1023), m = (int)(idx >> 10), g = ch >> 7, t = m & 127, mb = m - t;
        const float* wrow = F.w_sp + ((size_t)g * 128 + t) * 128;
        const float lw = F.ln_w[ch], lb = F.ln_b[ch];
        float s = 0.f;
        for (int sp = 0; sp <= t; ++sp) { const float vb = bf2f(F.proj[(size_t)(mb + sp) * PW + PC_VB + ch]);
            const float vnv = (vb - F.lnst[2 * (mb + sp)]) * F.lnst[2 * (mb + sp) + 1] * lw + lb; s = fmaf(wrow[sp], vnv, s); }
        s += F.b_sp[g * 128 + t];
        const float u = bf2f(F.proj[(size_t)m * PW + PC_UB + ch]), z = bf2f(F.proj[(size_t)m * PW + PC_ZB + ch]);
        F.concat[(size_t)m * MIXW + 1024 + ch] = (bf16)f2bf(u * s * silu(z));
    }
}
__device__ __forceinline__ void naive_gateA(Frame& F) {
    const int gw = F.vcu * NWAVES + F.wave, NGW = F.G * NWAVES, lane = F.lane;
    for (int it = gw; it < M * 8; it += NGW) {
        const int m = it >> 3, h = it & 7;
        const float* p = F.oraw + (size_t)m * 1024 + h * 128 + 2 * lane;
        const float a = p[0], b = p[1];
        const float sc = rsqrtf(wave_sum(a * a + b * b) * (1.f / 128.f) + EPS);
        const unsigned z = *(const unsigned*)(F.proj + (size_t)m * PW + PC_ZA + h * 128 + 2 * lane);
        *(unsigned*)(F.concat + (size_t)m * MIXW + h * 128 + 2 * lane) = pk2(a * sc * F.head_w[2 * lane] * silu(bflo(z)), b * sc * F.head_w[2 * lane + 1] * silu(bfhi(z)));
    }
}
__device__ __forceinline__ void p5_final(Frame& F) {
    const int gw = F.vcu * NWAVES + F.wave, NGW = F.G * NWAVES, lane = F.lane;
    for (int m = gw; m < M; m += NGW) {
        const float part = (lane < 32) ? F.rowss[(size_t)m * 32 + lane] : 0.f;
        const float rs = rsqrtf(wave_sum(part) * (1.f / DM) + EPS);
        GAS f32x4* o = (GAS f32x4*)(F.out + (size_t)m * DM) + lane;
#pragma unroll
        for (int j = 0; j < 8; ++j) { const f32x4 w = ((const GAS f32x4*)F.fin_w)[64 * j + lane]; f32x4 v = o[64 * j]; v = v * rs * w; o[64 * j] = v; }
    }
}

struct Args { const float* in[13]; float* out; unsigned char* ws; };
__global__ void __launch_bounds__(NWAVES * 64, 2) fwd_kernel(Args args) {
    extern __shared__ __attribute__((aligned(16))) unsigned char lds[];
    Frame F;
    F.lds = lds;
    F.tid = threadIdx.x; F.lane = F.tid & 63; F.wave = __builtin_amdgcn_readfirstlane(F.tid >> 6);
    F.G = gridDim.x; { const int bx = blockIdx.x; F.vcu = (F.G % 8 == 0) ? (bx % 8) * (F.G / 8) + bx / 8 : bx; }
    unsigned char* ws = args.ws;
    F.x = args.in[0]; F.norm_w = args.in[1]; F.w_in = args.in[2]; F.conv_w = args.in[3]; F.a_log = args.in[4]; F.dt_bias = args.in[5]; F.head_w = args.in[6];
    F.ln_w = args.in[7]; F.ln_b = args.in[8]; F.w_sp = args.in[9]; F.b_sp = args.in[10]; F.w_out = args.in[11]; F.fin_w = args.in[12]; F.out = args.out;
    F.Wt1 = (bf16*)(ws + WS_WT1); F.Wt2 = (bf16*)(ws + WS_WT2); F.XN = (bf16*)(ws + WS_XN); F.proj = (bf16*)(ws + WS_PROJ); F.concat = (bf16*)(ws + WS_CONCAT); F.act = (bf16*)(ws + WS_ACT);
    F.ab = (float*)(ws + WS_AB); F.gates = (float*)(ws + WS_GATES); F.lnst = (float*)(ws + WS_LNST); F.rowss = (float*)(ws + WS_ROWSS); F.oraw = (float*)(ws + WS_ORAW);
    LAS unsigned char* ldsl = (LAS unsigned char*)lds;
    for (int u = F.tid; u < (LDS_BYTES - LDSCTL_OFF) / 4; u += NWAVES * 64) ((LAS unsigned*)(ldsl + LDSCTL_OFF))[u] = 0u;
    __syncthreads();
    volatile LAS unsigned* MISC = (volatile LAS unsigned*)(ldsl + MISC_OFF);
    XcdBarrier bar = xcd_barrier_post((unsigned*)(ws + WS_CTL) + CW_BAR, MISC + 8);

    p0_prologue(F);
    xcd_barrier(bar);
    {
        pg8::Gemm g{F.XN, F.Wt1, M, PW, DM}; pg8::StaticOrder S; S.init(M, PW, F.G, (int)blockIdx.x);
        pg8::EpiBf16 E{F.proj, PW};
        pg8::gemm_phase<pg8::EpiBf16, pg8::StaticOrder, true, true>(ldsl + RING_OFF, g, S, E);
    }
    xcd_barrier(bar);
    naive_p2(F);
    xcd_barrier(bar);
    if (blockIdx.x < 32) naive_scan(F, blockIdx.x >> 3, blockIdx.x & 7); else naive_sgu(F, 32);
    xcd_barrier(bar);
    naive_gateA(F);
    xcd_barrier(bar);
    {
        pg8::Gemm g{F.concat, F.Wt2, M, DM, MIXW}; pg8::StaticOrder S; S.init(M, DM, F.G, (int)blockIdx.x);
        pg8::EpiResid E{F.x, F.out, DM, F.rowss};
        pg8::gemm_phase<pg8::EpiResid, pg8::StaticOrder, true, true>(ldsl + RING_OFF, g, S, E);
    }
    xcd_barrier(bar);
    p5_final(F);
}

extern "C" void kernel_launch(void* const* d_in, const int* in_sizes, int n_in, void* d_out, int out_size, void* d_ws, size_t ws_size, hipStream_t stream) {
    static int grid = 0;
    if (grid == 0) {
        int dev = 0, cus = 0;
        if (hipGetDevice(&dev) != hipSuccess || hipDeviceGetAttribute(&cus, hipDeviceAttributeMultiprocessorCount, dev) != hipSuccess) { fprintf(stderr, "kernel_launch: device query failed\n"); grid = -1; return; }
        if (hipFuncSetAttribute((const void*)fwd_kernel, hipFuncAttributeMaxDynamicSharedMemorySize, LDS_BYTES) != hipSuccess) { fprintf(stderr, "kernel_launch: hipFuncSetAttribute failed\n"); grid = -1; return; }
        int per_cu = 0;
        if (hipOccupancyMaxActiveBlocksPerMultiprocessor(&per_cu, (const void*)fwd_kernel, NWAVES * 64, LDS_BYTES) != hipSuccess || per_cu < 1) fprintf(stderr, "kernel_launch: occupancy query reports %d blocks per CU\n", per_cu);
        (void)hipGetLastError();
        grid = cus;
    }
    if (grid < 0) return;
    (void)hipMemsetAsync((char*)d_ws + WS_CTL, 0, CTL_ZERO_BYTES, stream);
    Args a{};
    for (int i = 0; i < 13; ++i) a.in[i] = (const float*)d_in[i];
    a.out = (float*)d_out; a.ws = (unsigned char*)d_ws;
    hipLaunchKernelGGL(fwd_kernel, dim3(grid), dim3(NWAVES * 64), LDS_BYTES, stream, a);
}
```

```cpp
#include <hip/hip_runtime.h>
#include <cstdio>
#include <cstdint>
namespace pg8 {
#define PG8_LAS __attribute__((address_space(3)))
typedef unsigned short bf16_t;
typedef short bf16x8 __attribute__((ext_vector_type(8)));
typedef float f32x4 __attribute__((ext_vector_type(4)));
typedef unsigned u32x4 __attribute__((ext_vector_type(4)));
constexpr int BM = 256, BK = 64, HALF = 128, HTB = HALF * BK * 2  , STAGE_BYTES = 8 * HTB, NXCD = 8, WGM = 8;

__host__ __device__ __forceinline__ int lds_byte(int r, int c) { const int st = (r >> 4) * 2 + (c >> 5), rr = r & 15, cc = c & 31, ob = rr * 64 + cc * 2; return st * 1024 + (ob ^ (((ob >> 9) & 1) << 5)); }
__host__ __device__ __forceinline__ void stage_rc(int b, int& R, int& C) { const int st = b / 1024, sb = b % 1024, swz = sb ^ (((sb >> 9) & 1) << 5); R = (st >> 1) * 16 + swz / 64; C = (st & 1) * 32 + (swz % 64) / 2; }
__host__ __device__ __forceinline__ int perm32(int rho) { const int n = rho >> 4, i = rho & 15; return 8 * (i >> 2) + 4 * n + (i & 3); }

struct Unit { int pm, pn; };
struct Gemm { const bf16_t* A; const bf16_t* Bt; int M, N, K; };

struct StaticOrder {
    int nM, nN, nwg, G, c;
    __host__ __device__ void init(int M, int N, int G_, int c_) { nM = M / BM; nN = N / BM; nwg = nM * nN; G = G_; c = c_; }
    __host__ __device__ bool next(int i, Unit& u) const {
        const long L = (long)i * G + c; if (L >= nwg) return false;
        int wgid = (int)L; { const int q = nwg / NXCD, r = nwg % NXCD, xcd = wgid % NXCD, off = wgid / NXCD; wgid = (xcd < r ? xcd * (q + 1) : r * (q + 1) + (xcd - r) * q) + off; }
        const int nig = WGM * nN, gid = wgid / nig, fm = gid * WGM, gsz = (nM - fm) < WGM ? (nM - fm) : WGM;
        u.pm = fm + ((wgid % nig) % gsz); u.pn = (wgid % nig) / gsz; return true;
    }
    __device__ __forceinline__ void a_ready(const Unit&) const {}
    __device__ __forceinline__ void done(const Unit&) const {}
};


__device__ __forceinline__ unsigned cvt_pk_bf16(float lo, float hi) { unsigned r; asm volatile("v_cvt_pk_bf16_f32 %0, %1, %2" : "=v"(r) : "v"(lo), "v"(hi)); return r; }
struct EpiBf16 {
    static constexpr bool PERM = true, AFTER_DRAIN = false;
    bf16_t* O; int ldc;
    __device__ __forceinline__ void operator()(const f32x4 (&acc)[2][2][4][2], const Unit& u, int wr, int wc, int fr, int fq) const {
        const int row0 = u.pm * BM + wr * 64 + fr; const int col0 = u.pn * BM + wc * 32 + 8 * fq;
#pragma unroll
        for (int ai = 0; ai < 2; ++ai)
#pragma unroll
            for (int m = 0; m < 4; ++m) { bf16_t* rowp = O + (size_t)(row0 + ai * HALF + m * 16) * ldc + col0;
#pragma unroll
                for (int bj = 0; bj < 2; ++bj) { const f32x4 v0 = acc[ai][bj][m][0], v1 = acc[ai][bj][m][1];
                    u32x4 w; w.x = cvt_pk_bf16(v0[0], v0[1]); w.y = cvt_pk_bf16(v0[2], v0[3]); w.z = cvt_pk_bf16(v1[0], v1[1]); w.w = cvt_pk_bf16(v1[2], v1[3]);
                    *(u32x4*)(rowp + bj * HALF) = w; } }
    }
};
struct EpiResid {
    static constexpr bool PERM = false, AFTER_DRAIN = false;
    const float* base; float* out; int ldc; float* rowss;
    __device__ __forceinline__ void operator()(const f32x4 (&acc)[2][2][4][2], const Unit& u, int wr, int wc, int fr, int fq) const {
        const int row0 = u.pm * BM + wr * 64 + fr, col0 = u.pn * BM + wc * 32 + 4 * fq;
#pragma unroll
        for (int ai = 0; ai < 2; ++ai)
#pragma unroll
            for (int m = 0; m < 4; ++m) { const int row = row0 + ai * HALF + m * 16; const size_t off = (size_t)row * ldc + col0; float ss = 0.f;
#pragma unroll
                for (int bj = 0; bj < 2; ++bj)
#pragma unroll
                    for (int n = 0; n < 2; ++n) { const f32x4 b = *(const f32x4*)(base + off + bj * HALF + n * 16); const f32x4 o = b + acc[ai][bj][m][n];
                        *(f32x4*)(out + off + bj * HALF + n * 16) = o; ss += (o[0] * o[0] + o[1] * o[1]) + (o[2] * o[2] + o[3] * o[3]); }
                ss += __shfl_xor(ss, 16); ss += __shfl_xor(ss, 32);
                if (fq == 0) rowss[(size_t)row * 32 + u.pn * 4 + wc] = ss; }
    }
};

template <class Epi, class Sched, bool ALIGN_EPI = false, bool SP2 = false>
__device__ __forceinline__ void gemm_phase(PG8_LAS unsigned char* lds, const Gemm g, const Sched& S, const Epi& E) {
    const int tid = threadIdx.x, wid = __builtin_amdgcn_readfirstlane(tid >> 6), lane = tid & 63, wr = wid >> 2, wc = wid & 3, fr = lane & 15, fq = lane >> 4;
    const int K = g.K, nt = K / BK;
    unsigned voffA[2], voffB[2];
#pragma unroll
    for (int i = 0; i < 2; ++i) { int R, C; stage_rc(tid * 16 + i * 8192, R, C); const int Rb = Epi::PERM ? ((R & ~31) + perm32(R & 31)) : R;
        voffA[i] = (unsigned)(R * K + C) * 2u; voffB[i] = (unsigned)(Rb * K + C) * 2u; }
    const size_t kstep = (size_t)(BK * 2);
    const size_t hstep = (size_t)HALF * K * 2;
    const size_t tstep = 2 * hstep;
    const unsigned ldsw = (unsigned)wid * 1024u;
    const int aoff = lds_byte(wr * 64 + fr, fq * 8), boff = lds_byte(wc * 32 + fr, fq * 8);
#define PG8_SA(b, h) (((b) * 2 + (h)) * HTB)
#define PG8_SB(b, h) ((4 + (b) * 2 + (h)) * HTB)
#define PG8_STAGE(bufoff, gbase, voff) do { _Pragma("unroll") for (int _i = 0; _i < 2; ++_i) \
        __builtin_amdgcn_global_load_lds((const unsigned*)((const char*)(gbase) + (voff)[_i]), (PG8_LAS unsigned*)(lds + (bufoff) + ldsw + _i * 8192), 16, 0, 0); } while (0)
#define PG8_LDA(dst, b, h) do { _Pragma("unroll") for (int m = 0; m < 4; ++m) _Pragma("unroll") for (int k = 0; k < 2; ++k) dst[m][k] = *(const PG8_LAS bf16x8*)(lds + PG8_SA(b, h) + aoff + m * 2048 + k * 1024); } while (0)
#define PG8_LDB(dst, b, h) do { _Pragma("unroll") for (int n = 0; n < 2; ++n) _Pragma("unroll") for (int k = 0; k < 2; ++k) dst[n][k] = *(const PG8_LAS bf16x8*)(lds + PG8_SB(b, h) + boff + n * 2048 + k * 1024); } while (0)
#define PG8_MMA(ai, bj, At, Bt) do { __builtin_amdgcn_s_setprio(1); _Pragma("unroll") for (int m = 0; m < 4; ++m) _Pragma("unroll") for (int n = 0; n < 2; ++n) _Pragma("unroll") for (int k = 0; k < 2; ++k) \
        acc[ai][bj][m][n] = __builtin_amdgcn_mfma_f32_16x16x32_bf16(Bt[n][k], At[m][k], acc[ai][bj][m][n], 0, 0, 0); __builtin_amdgcn_s_setprio(0); } while (0)
#define PG8_WAIT_V(n) asm volatile("s_waitcnt vmcnt(" #n ")" ::: "memory")
#define PG8_WAIT_L(n) asm volatile("s_waitcnt lgkmcnt(" #n ")" ::: "memory")
#define PG8_BAR __builtin_amdgcn_s_barrier()
#define PG8_SCHED __builtin_amdgcn_sched_barrier(0)
    Unit cur, nxt; int ui = 0;
    if (!S.next(0, cur)) return;
    f32x4 acc[2][2][4][2];
#pragma unroll
    for (int a = 0; a < 2; ++a)
#pragma unroll
        for (int b = 0; b < 2; ++b)
#pragma unroll
            for (int m = 0; m < 4; ++m)
#pragma unroll
                for (int n = 0; n < 2; ++n) acc[a][b][m][n] = (f32x4){0.f, 0.f, 0.f, 0.f};
    bf16x8 At[4][2], B0[2][2], B1[2][2];
    const char* cA = (const char*)g.A + (size_t)cur.pm * tstep; const char* cB = (const char*)g.Bt + (size_t)cur.pn * tstep;
    S.a_ready(cur);
    if constexpr (SP2) {
        PG8_STAGE(PG8_SB(0, 0), cB, voffB); PG8_STAGE(PG8_SB(0, 1), cB + hstep, voffB); PG8_STAGE(PG8_SA(0, 0), cA, voffA); PG8_STAGE(PG8_SA(0, 1), cA + hstep, voffA);
        if (wr == 1) PG8_BAR;
        PG8_WAIT_V(2); PG8_BAR;
        PG8_STAGE(PG8_SB(1, 0), cB + kstep, voffB); PG8_STAGE(PG8_SA(1, 0), cA + kstep, voffA); PG8_STAGE(PG8_SB(1, 1), cB + hstep + kstep, voffB);
        PG8_WAIT_V(6); PG8_BAR;
    } else {
        PG8_STAGE(PG8_SB(0, 0), cB, voffB); PG8_STAGE(PG8_SA(0, 0), cA, voffA); PG8_STAGE(PG8_SB(0, 1), cB + hstep, voffB); PG8_STAGE(PG8_SA(0, 1), cA + hstep, voffA);
        if (wr == 1) PG8_BAR;
        PG8_WAIT_V(4); PG8_BAR;
        PG8_STAGE(PG8_SB(1, 0), cB + kstep, voffB); PG8_STAGE(PG8_SA(1, 0), cA + kstep, voffA); PG8_STAGE(PG8_SB(1, 1), cB + hstep + kstep, voffB);
        PG8_WAIT_V(6); PG8_BAR;
    }
    for (;;) {
        const bool has_next = S.next(ui + 1, nxt);
        const char* nA = has_next ? (const char*)g.A + (size_t)nxt.pm * tstep : cA; const char* nB = has_next ? (const char*)g.Bt + (size_t)nxt.pn * tstep : cB;
        for (int t = 0; t < nt; t += 2) {
            const bool last = (t == nt - 2);
            const char* a1 = cA + (size_t)(t + 1) * kstep;
            const char* a2 = last ? nA : cA + (size_t)(t + 2) * kstep; const char* b2 = last ? nB : cB + (size_t)(t + 2) * kstep;
            const char* a3 = a2 + kstep; const char* b3 = b2 + kstep;
            if (last && has_next) S.a_ready(nxt);
            if constexpr (SP2) {
            PG8_LDB(B0, 0, 0); PG8_LDB(B1, 0, 1); PG8_SCHED; PG8_LDA(At, 0, 0); PG8_STAGE(PG8_SA(1, 1), a1 + hstep, voffA);
            PG8_WAIT_V(8); PG8_WAIT_L(0); PG8_BAR; PG8_MMA(0, 0, At, B0); PG8_MMA(0, 1, At, B1); PG8_BAR; PG8_SCHED;
            PG8_LDA(At, 0, 1); PG8_STAGE(PG8_SB(0, 0), b2, voffB); PG8_STAGE(PG8_SB(0, 1), b2 + hstep, voffB); PG8_STAGE(PG8_SA(0, 0), a2, voffA);
            PG8_WAIT_V(8); PG8_WAIT_L(0); PG8_BAR; PG8_MMA(1, 0, At, B0); PG8_MMA(1, 1, At, B1); PG8_BAR; PG8_SCHED;
            PG8_LDB(B0, 1, 0); PG8_LDB(B1, 1, 1); PG8_SCHED; PG8_LDA(At, 1, 0); PG8_STAGE(PG8_SA(0, 1), a2 + hstep, voffA);
            PG8_WAIT_V(8); PG8_WAIT_L(0); PG8_BAR; PG8_MMA(0, 0, At, B0); PG8_MMA(0, 1, At, B1); PG8_BAR; PG8_SCHED;
            PG8_LDA(At, 1, 1); PG8_STAGE(PG8_SB(1, 0), b3, voffB); PG8_STAGE(PG8_SB(1, 1), b3 + hstep, voffB); PG8_STAGE(PG8_SA(1, 0), a3, voffA);
            PG8_WAIT_V(8); PG8_WAIT_L(0); PG8_BAR; PG8_MMA(1, 0, At, B0); PG8_MMA(1, 1, At, B1); PG8_BAR; PG8_SCHED;
            } else {
            PG8_LDB(B0, 0, 0); PG8_SCHED; PG8_LDA(At, 0, 0); PG8_STAGE(PG8_SA(1, 1), a1 + hstep, voffA);
            PG8_WAIT_L(8); PG8_BAR; PG8_WAIT_L(0); PG8_MMA(0, 0, At, B0); PG8_BAR; PG8_SCHED;
            PG8_LDB(B1, 0, 1); PG8_STAGE(PG8_SB(0, 0), b2, voffB);
            PG8_BAR; PG8_WAIT_L(0); PG8_MMA(0, 1, At, B1); PG8_BAR;
            PG8_LDA(At, 0, 1); PG8_STAGE(PG8_SA(0, 0), a2, voffA);
            PG8_BAR; PG8_WAIT_L(0); PG8_MMA(1, 0, At, B0); PG8_BAR; PG8_SCHED;
            PG8_STAGE(PG8_SB(0, 1), b2 + hstep, voffB);
            PG8_WAIT_V(6); PG8_BAR; PG8_MMA(1, 1, At, B1); PG8_BAR;
            PG8_LDB(B0, 1, 0); PG8_SCHED; PG8_LDA(At, 1, 0); PG8_STAGE(PG8_SA(0, 1), a2 + hstep, voffA);
            PG8_WAIT_L(8); PG8_BAR; PG8_WAIT_L(0); PG8_MMA(0, 0, At, B0); PG8_BAR; PG8_SCHED;
            PG8_LDB(B1, 1, 1); PG8_STAGE(PG8_SB(1, 0), b3, voffB);
            PG8_BAR; PG8_WAIT_L(0); PG8_MMA(0, 1, At, B1); PG8_BAR;
            PG8_LDA(At, 1, 1); PG8_STAGE(PG8_SA(1, 0), a3, voffA);
            PG8_BAR; PG8_WAIT_L(0); PG8_MMA(1, 0, At, B0); PG8_BAR; PG8_SCHED;
            PG8_STAGE(PG8_SB(1, 1), b3 + hstep, voffB);
            PG8_WAIT_V(6); PG8_BAR; PG8_MMA(1, 1, At, B1); PG8_BAR;
            }
        }
        if constexpr (ALIGN_EPI) { if (wr == 0) PG8_BAR; }
        if constexpr (!Epi::AFTER_DRAIN) { E(acc, cur, wr, wc, fr, fq); S.done(cur); }
        if (!has_next) break;
#pragma unroll
        for (int a = 0; a < 2; ++a)
#pragma unroll
            for (int b = 0; b < 2; ++b)
#pragma unroll
                for (int m = 0; m < 4; ++m)
#pragma unroll
                    for (int n = 0; n < 2; ++n) acc[a][b][m][n] = (f32x4){0.f, 0.f, 0.f, 0.f};
        cur = nxt; cA = nA; cB = nB; ++ui;
        if constexpr (ALIGN_EPI) { if (wr == 1) PG8_BAR; }
    }
    PG8_WAIT_V(0);
    if constexpr (!ALIGN_EPI) { if (wr == 0) PG8_BAR; }
    PG8_BAR;
    if constexpr (Epi::AFTER_DRAIN) { E.fused(acc, cur, wr, wc, fr, fq, lds, wid, lane); S.done(cur); }
#undef PG8_SA
#undef PG8_SB
#undef PG8_STAGE
#undef PG8_LDA
#undef PG8_LDB
#undef PG8_MMA
#undef PG8_WAIT_V
#undef PG8_WAIT_L
#undef PG8_BAR
#undef PG8_SCHED
}
}

constexpr int NWAVES = 8;
constexpr int BATCH = 4, SEQ = 4096, DM = 2048, M = BATCH * SEQ;
constexpr int AH = 8, INW = 7184, PW = 7168, MIXW = 2048;
constexpr int PC_ZA = 3072, PC_UB = 4096, PC_VB = 5120, PC_ZB = 6144;
constexpr float EPS = 1e-6f;
constexpr size_t MiB = 1u << 20;
constexpr size_t WS_CTL = 0, CTL_ZERO_BYTES = 1 * MiB;
constexpr size_t WS_WT1 = 2 * MiB;
constexpr size_t WS_WT2 = 30 * MiB;
constexpr size_t WS_XN = 40 * MiB;
constexpr size_t WS_ORAW = 40 * MiB;
constexpr size_t WS_PROJ = 104 * MiB;
constexpr size_t WS_CONCAT = 328 * MiB;
constexpr size_t WS_AB = 392 * MiB, WS_GATES = 393 * MiB, WS_LNST = 394 * MiB, WS_ROWSS = 395 * MiB;
constexpr size_t WS_ACT = 400 * MiB;
constexpr int CW_BAR = 4096;
constexpr int RING_OFF = 0, RING_BYTES = 147456;
constexpr int LDSCTL_OFF = RING_BYTES, MISC_OFF = LDSCTL_OFF + 320;
constexpr int LDS_BYTES = 149504;

#define GAS __attribute__((address_space(1)))
#define LAS __attribute__((address_space(3)))
typedef unsigned short bf16;
typedef unsigned v4u __attribute__((ext_vector_type(4)));
typedef unsigned v2u __attribute__((ext_vector_type(2)));
typedef float f32x4 __attribute__((ext_vector_type(4)));
typedef GAS unsigned gu32;
#define RLX_AGENT __ATOMIC_RELAXED, __HIP_MEMORY_SCOPE_AGENT
#define LDS_WAIT() asm volatile("s_waitcnt lgkmcnt(0)" ::: "memory")
#define VM_WAIT() asm volatile("s_waitcnt vmcnt(0)" ::: "memory")
__device__ __forceinline__ unsigned f2bf(float f) { unsigned u = __builtin_bit_cast(unsigned, f); return (u + 0x7fffu + ((u >> 16) & 1u)) >> 16; }
__device__ __forceinline__ unsigned pk2(float lo, float hi) { return f2bf(lo) | (f2bf(hi) << 16); }
__device__ __forceinline__ float bf2f(unsigned b) { return __uint_as_float(b << 16); }
__device__ __forceinline__ float bflo(unsigned w) { return __uint_as_float(w << 16); }
__device__ __forceinline__ float bfhi(unsigned w) { return __uint_as_float(w & 0xffff0000u); }
__device__ __forceinline__ float silu(float x) { return x / (1.f + __expf(-x)); }
__device__ __forceinline__ float sigmoidf_(float x) { return 1.f / (1.f + __expf(-x)); }
__device__ __forceinline__ float softplus_(float x) { return fmaxf(x, 0.f) + log1pf(__expf(-fabsf(x))); }
__device__ __forceinline__ float wave_sum(float v) {
#pragma unroll
    for (int o = 1; o < 64; o <<= 1) v += __shfl_xor(v, o);
    return v;
}

#define XB_TMO      128
#define XB_XCNT(j)  (256  + 64 * (j))
#define XB_XSUB(j)  (1280 + 64 * (j))
#define XB_XGEN(j)  (2304 + 64 * (j))
#define XB_TOP      3328
#define XB_TOPGEN   3392
#define XCD_BAR_WORDS 3456
#define XB_SPIN_CAP (1u << 18)

__device__ __forceinline__ unsigned xb_ld(unsigned* p)              { return __hip_atomic_load(p, __ATOMIC_RELAXED, __HIP_MEMORY_SCOPE_AGENT); }
__device__ __forceinline__ unsigned xb_add(unsigned* p, unsigned v) { return __hip_atomic_fetch_add(p, v, __ATOMIC_RELAXED, __HIP_MEMORY_SCOPE_AGENT); }
__device__ __forceinline__ unsigned xb_xcc_id() { return (unsigned)__builtin_amdgcn_s_getreg((3 << 11) | 20) & 0xFu; }
#define XB_SPIN(cond, bar) do { unsigned _sp = 0; while (cond) { __builtin_amdgcn_s_sleep(1); \
    if ((++_sp & 255u) == 0u) { if (xb_ld(&(bar)[XB_TMO])) break; if (_sp > XB_SPIN_CAP) { atomicAdd(&(bar)[XB_TMO], 1u); break; } } } } while (0)

struct XcdBarrier {
    unsigned* bar; unsigned x;
    volatile LAS unsigned* st;
};

__device__ __forceinline__ XcdBarrier xcd_barrier_post(unsigned* bar, volatile LAS unsigned* st) {
    XcdBarrier b; b.bar = bar; b.x = xb_xcc_id(); b.st = st;
    if (threadIdx.x == 0) (void)xb_add(&bar[XB_XCNT(b.x)], 1u);
    return b;
}
__device__ __forceinline__ void xcd_barrier_complete(unsigned* bar, unsigned x, unsigned& nloc, unsigned& nx) {
    const unsigned G = gridDim.x * gridDim.y * gridDim.z;
    unsigned sum, cnt, mine, sp = 0u;
    for (;;) {
        sum = 0u; cnt = 0u; mine = 0u;
#pragma unroll
        for (unsigned j = 0; j < 16; ++j) { const unsigned c = xb_ld(&bar[XB_XCNT(j)]); sum += c; cnt += (c > 0u) ? 1u : 0u; mine = (j == x) ? c : mine; }
        if (sum == G) break;
        __builtin_amdgcn_s_sleep(1);
        if ((++sp & 255u) == 0u) { if (xb_ld(&bar[XB_TMO])) break; if (sp > XB_SPIN_CAP) { atomicAdd(&bar[XB_TMO], 1u); break; } }
    }
    nloc = mine > 0u ? mine : 1u; nx = cnt > 0u ? cnt : 1u;
}

__device__ __forceinline__ void xcd_barrier(const XcdBarrier& b) {
    asm volatile("s_waitcnt vmcnt(0)" ::: "memory");
    __syncthreads();
    if (threadIdx.x == 0) {
        unsigned* bar = b.bar;
        __builtin_amdgcn_s_waitcnt(0);
        unsigned nloc = b.st[0], nx = b.st[1];
        if (nloc == 0u) { xcd_barrier_complete(bar, b.x, nloc, nx); b.st[0] = nloc; b.st[1] = nx; }
        const unsigned old = xb_add(&bar[XB_XSUB(b.x)], 1u);
        const unsigned gen = old / nloc;
        if (old + 1u == (gen + 1u) * nloc) {
            __builtin_amdgcn_fence(__ATOMIC_RELEASE, "agent");
            asm volatile("s_waitcnt vmcnt(0)" ::: "memory");
            const unsigned og = xb_add(&bar[XB_TOP], 1u);
            const unsigned tg = og / nx;
            if (og + 1u == (tg + 1u) * nx) xb_add(&bar[XB_TOPGEN], 1u);
            else XB_SPIN(xb_ld(&bar[XB_TOPGEN]) == tg, bar);
            __builtin_amdgcn_fence(__ATOMIC_ACQUIRE, "agent");
            xb_add(&bar[XB_XGEN(b.x)], 1u);
            asm volatile("s_waitcnt vmcnt(0)" ::: "memory");
        } else {
            XB_SPIN(xb_ld(&bar[XB_XGEN(b.x)]) == gen, bar);
            __builtin_amdgcn_fence(__ATOMIC_ACQUIRE, "agent");
            asm volatile("s_waitcnt vmcnt(0)" ::: "memory");
        }
    }
    __syncthreads();
}


struct Frame {
    unsigned char* lds;
    unsigned char* ws;
    int tid, lane, wave, vcu, G;
    const float *x, *norm_w, *w_in, *conv_w, *a_log, *dt_bias, *head_w, *ln_w, *ln_b, *w_sp, *b_sp, *w_out, *fin_w;
    float* out;
    bf16 *Wt1, *Wt2, *XN, *proj, *concat, *act;
    float *ab, *gates, *lnst, *rowss, *oraw;
};

__device__ __forceinline__ void p0_transpose_item(const float* W, int srcN, int src_n0, int k0, bf16* WT, int K, int dst_row0, LAS float* scr, int lane) {
#pragma unroll 8
    for (int i = 0; i < 32; ++i) { const int kk = 2 * i + (lane >> 5); scr[kk * 33 + (lane & 31)] = W[(size_t)(k0 + kk) * srcN + src_n0 + (lane & 31)]; }
    LDS_WAIT(); asm volatile("" ::: "memory");
    const int c = lane & 7;
#pragma unroll
    for (int j = 0; j < 4; ++j) { const int n = (lane >> 3) + 8 * j; const LAS float* s = scr + (8 * c) * 33 + n;
        v4u o; o.x = pk2(s[0 * 33], s[1 * 33]); o.y = pk2(s[2 * 33], s[3 * 33]); o.z = pk2(s[4 * 33], s[5 * 33]); o.w = pk2(s[6 * 33], s[7 * 33]);
        *(GAS v4u*)(WT + (size_t)(dst_row0 + n) * K + k0 + 8 * c) = o; }
    LDS_WAIT(); asm volatile("" ::: "memory");
}
__device__ __forceinline__ void p0_prologue(Frame& F) {
    LAS float* scr = (LAS float*)((LAS unsigned char*)F.lds + RING_OFF + F.wave * 16384);
    const int gw = F.vcu * NWAVES + F.wave, NGW = F.G * NWAVES;
    constexpr int I_1 = (DM / 64) * (PW / 32), I_2 = (MIXW / 64) * (DM / 32);
    for (int it = gw; it < I_1 + I_2; it += NGW) {
        if (it < I_1) { const int kb = it / (PW / 32), nb = it % (PW / 32), n0 = 32 * nb;
            p0_transpose_item(F.w_in, INW, n0 + (n0 >= 4096 ? 16 : 0), 64 * kb, F.Wt1, DM, n0, scr, F.lane); }
        else { const int r = it - I_1, kb = r / (DM / 32), nb = r % (DM / 32);
            p0_transpose_item(F.w_out, DM, 32 * nb, 64 * kb, F.Wt2, MIXW, 32 * nb, scr, F.lane); }
    }
    __syncthreads();
    LAS float* Wl = (LAS float*)((LAS unsigned char*)F.lds + RING_OFF);
    for (int idx = F.tid; idx < 16 * DM; idx += NWAVES * 64) { const int k = idx >> 4, c = idx & 15; Wl[c * DM + k] = F.w_in[(size_t)k * INW + 4096 + c] * F.norm_w[k]; }
    __syncthreads();
    for (int mp = gw; mp < M / 2; mp += NGW) {
        const int m0 = 2 * mp;
        const GAS f32x4* x0 = (const GAS f32x4*)(F.x + (size_t)m0 * DM) + F.lane;
        const GAS f32x4* x1 = (const GAS f32x4*)(F.x + (size_t)(m0 + 1) * DM) + F.lane;
        f32x4 v0[8], v1[8]; float s0 = 0.f, s1 = 0.f;
#pragma unroll
        for (int j = 0; j < 8; ++j) { v0[j] = x0[64 * j]; v1[j] = x1[64 * j]; }
#pragma unroll
        for (int j = 0; j < 8; ++j) { s0 += (v0[j].x * v0[j].x + v0[j].y * v0[j].y) + (v0[j].z * v0[j].z + v0[j].w * v0[j].w);
                                      s1 += (v1[j].x * v1[j].x + v1[j].y * v1[j].y) + (v1[j].z * v1[j].z + v1[j].w * v1[j].w); }
        const float r0 = rsqrtf(wave_sum(s0) * (1.f / DM) + EPS), r1 = rsqrtf(wave_sum(s1) * (1.f / DM) + EPS);
        float acc[32];
#pragma unroll
        for (int i = 0; i < 32; ++i) acc[i] = 0.f;
#pragma unroll
        for (int j = 0; j < 8; ++j)
#pragma unroll
            for (int c = 0; c < 16; ++c) { const f32x4 w = *(const LAS f32x4*)(Wl + c * DM + 256 * j + 4 * F.lane);
                acc[c] += (v0[j].x * w.x + v0[j].y * w.y) + (v0[j].z * w.z + v0[j].w * w.w);
                acc[16 + c] += (v1[j].x * w.x + v1[j].y * w.y) + (v1[j].z * w.z + v1[j].w * w.w);
                if ((c & 7) == 7) asm volatile("" ::: "memory"); }
#pragma unroll
        for (int i = 0; i < 16; ++i) { const bool up = F.lane & 32; const float send = up ? acc[i] : acc[i + 16], keep = up ? acc[i + 16] : acc[i]; acc[i] = keep + __shfl_xor(send, 32); }
#pragma unroll
        for (int i = 0; i < 8; ++i) { const bool up = F.lane & 16; const float send = up ? acc[i] : acc[i + 8], keep = up ? acc[i + 8] : acc[i]; acc[i] = keep + __shfl_xor(send, 16); }
#pragma unroll
        for (int i = 0; i < 4; ++i) { const bool up = F.lane & 8; const float send = up ? acc[i] : acc[i + 4], keep = up ? acc[i + 4] : acc[i]; acc[i] = keep + __shfl_xor(send, 8); }
#pragma unroll
        for (int i = 0; i < 2; ++i) { const bool up = F.lane & 4; const float send = up ? acc[i] : acc[i + 2], keep = up ? acc[i + 2] : acc[i]; acc[i] = keep + __shfl_xor(send, 4); }
        { const bool up = F.lane & 2; const float send = up ? acc[0] : acc[1], keep = up ? acc[1] : acc[0]; acc[0] = keep + __shfl_xor(send, 2); }
        acc[0] += __shfl_xor(acc[0], 1);
        if ((F.lane & 1) == 0) { const int i = F.lane >> 1; const int r = i >> 4, c = i & 15; F.ab[(size_t)(m0 + r) * 16 + c] = acc[0] * (r ? r1 : r0); }
        GAS unsigned long long* o0 = (GAS unsigned long long*)(F.XN + (size_t)m0 * DM) + F.lane;
        GAS unsigned long long* o1 = (GAS unsigned long long*)(F.XN + (size_t)(m0 + 1) * DM) + F.lane;
#pragma unroll
        for (int j = 0; j < 8; ++j) { const f32x4 nw = ((const GAS f32x4*)F.norm_w)[64 * j + F.lane];
            o0[64 * j] = (unsigned long long)pk2(v0[j].x * r0 * nw.x, v0[j].y * r0 * nw.y) | ((unsigned long long)pk2(v0[j].z * r0 * nw.z, v0[j].w * r0 * nw.w) << 32);
            o1[64 * j] = (unsigned long long)pk2(v1[j].x * r1 * nw.x, v1[j].y * r1 * nw.y) | ((unsigned long long)pk2(v1[j].z * r1 * nw.z, v1[j].w * r1 * nw.w) << 32); }
    }
}

__device__ __forceinline__ void naive_lnst(Frame& F) {
    const int gw = F.vcu * NWAVES + F.wave, NGW = F.G * NWAVES, lane = F.lane;
    for (int m = gw; m < M; m += NGW) {
        const v4u* p = (const v4u*)(F.proj + (size_t)m * PW + PC_VB + 16 * lane);
        const v4u a = p[0], b = p[1]; const unsigned w[8] = {a.x, a.y, a.z, a.w, b.x, b.y, b.z, b.w};
        float v[16]; float s = 0.f;
#pragma unroll
        for (int i = 0; i < 8; ++i) { v[2 * i] = bflo(w[i]); v[2 * i + 1] = bfhi(w[i]); s += v[2 * i] + v[2 * i + 1]; }
        const float mu = wave_sum(s) * (1.f / 1024.f); float q = 0.f;
#pragma unroll
        for (int i = 0; i < 16; ++i) { const float d = v[i] - mu; q += d * d; }
        const float rs = rsqrtf(wave_sum(q) * (1.f / 1024.f) + EPS);
        if (lane == 0) { F.lnst[2 * m] = mu; F.lnst[2 * m + 1] = rs; }
    }
}
__device__ __forceinline__ void naive_conv_gates(Frame& F) {
    const int gw = F.vcu * NWAVES + F.wave, NGW = F.G * NWAVES, lane = F.lane;
    for (int it = gw; it < M * 24; it += NGW) {
        const int m = it / 24, r = it % 24, t = m % SEQ, c = r * 128 + 2 * lane;
        float s0 = 0.f, s1 = 0.f;
#pragma unroll
        for (int j = 0; j < 4; ++j) { if (t - 3 + j >= 0) { const unsigned w = *(const unsigned*)(F.proj + (size_t)(m - 3 + j) * PW + c);
            s0 += F.conv_w[j * 3072 + c] * bflo(w); s1 += F.conv_w[j * 3072 + c + 1] * bfhi(w); } }
        s0 = silu(s0); s1 = silu(s1);
        if (r < 16) { const float sc = rsqrtf(wave_sum(s0 * s0 + s1 * s1) + EPS); s0 *= sc; s1 *= sc; }
        *(unsigned*)(F.act + (size_t)m * 3072 + c) = pk2(s0, s1);
    }
    for (int idx = (F.vcu * NWAVES * 64) + F.tid; idx < M * 8; idx += F.G * NWAVES * 64) {
        const int m = idx >> 3, h = idx & 7;
        F.gates[(size_t)m * 16 + h] = sigmoidf_(F.ab[(size_t)m * 16 + h]);
        F.gates[(size_t)m * 16 + 8 + h] = -__expf(F.a_log[h]) * softplus_(F.ab[(size_t)m * 16 + 8 + h] + F.dt_bias[h]);
    }
}
__device__ __forceinline__ void naive_scan(Frame& F, int b, int h) {
    float* kq = (float*)(F.lds + RING_OFF);
    const int tid = F.tid, e = (tid >> 1) & 127, half = tid & 1;
    float S[64];
#pragma unroll
    for (int d = 0; d < 64; ++d) S[d] = 0.f;
    const size_t m0 = (size_t)b * SEQ;
    const int ldcol = (tid < 128) ? (1024 + h * 128 + tid) : (h * 128 + ((tid - 128) & 127));
    float nkq = bf2f(F.act[m0 * 3072 + ldcol]), nv = bf2f(F.act[m0 * 3072 + 2048 + h * 128 + e]);
    for (int t = 0; t < SEQ; ++t) {
        const size_t m = m0 + t; const int buf = t & 1;
        if (tid < 256) kq[buf * 256 + tid] = nkq;
        const float v = nv;
        if (t + 1 < SEQ) { nkq = bf2f(F.act[(m + 1) * 3072 + ldcol]); nv = bf2f(F.act[(m + 1) * 3072 + 2048 + h * 128 + e]); }
        __syncthreads();
        if (tid < 256) {
            const float beta = F.gates[m * 16 + h], a = __expf(F.gates[m * 16 + 8 + h]);
            const float* kk = kq + buf * 256 + half * 64; const float* qq = kq + buf * 256 + 128 + half * 64;
            float k0 = 0.f, k1 = 0.f, k2 = 0.f, k3 = 0.f;
#pragma unroll
            for (int d = 0; d < 64; d += 4) { const float4 k4 = *(const float4*)(kk + d);
                k0 = fmaf(k4.x, S[d], k0); k1 = fmaf(k4.y, S[d + 1], k1); k2 = fmaf(k4.z, S[d + 2], k2); k3 = fmaf(k4.w, S[d + 3], k3); }
            float kS = (k0 + k1) + (k2 + k3); kS += __shfl_xor(kS, 1);
            const float vn = beta * (v - a * kS);
            float o0 = 0.f, o1 = 0.f, o2 = 0.f, o3 = 0.f;
#pragma unroll
            for (int d = 0; d < 64; d += 4) { const float4 k4 = *(const float4*)(kk + d); const float4 q4 = *(const float4*)(qq + d);
                S[d] = fmaf(a, S[d], k4.x * vn); S[d + 1] = fmaf(a, S[d + 1], k4.y * vn); S[d + 2] = fmaf(a, S[d + 2], k4.z * vn); S[d + 3] = fmaf(a, S[d + 3], k4.w * vn);
                o0 = fmaf(q4.x, S[d], o0); o1 = fmaf(q4.y, S[d + 1], o1); o2 = fmaf(q4.z, S[d + 2], o2); o3 = fmaf(q4.w, S[d + 3], o3); }
            float o = (o0 + o1) + (o2 + o3); o += __shfl_xor(o, 1);
            if (half == 0) F.oraw[m * 1024 + h * 128 + e] = o * 0.08838834764831845f;
        }
    }
}
__device__ __forceinline__ void naive_sgu(Frame& F, int first_block) {
    const size_t nthr = (size_t)(F.G - first_block) * NWAVES * 64;
    for (size_t idx = (size_t)(blockIdx.x - first_block) * NWAVES * 64 + F.tid; idx < (size_t)M * 1024; idx += nthr) {
        const int ch = (int)(idx & 1023), m = (int)(idx >> 10), g = ch >> 7, t = m & 127, mb = m - t;
        const float* wrow = F.w_sp + ((size_t)g * 128 + t) * 128;
        const float lw = F.ln_w[ch], lb = F.ln_b[ch];
        float s = 0.f;
        for (int sp = 0; sp <= t; ++sp) { const float vb = bf2f(F.proj[(size_t)(mb + sp) * PW + PC_VB + ch]);
            const float vnv = (vb - F.lnst[2 * (mb + sp)]) * F.lnst[2 * (mb + sp) + 1] * lw + lb; s = fmaf(wrow[sp], vnv, s); }
        s += F.b_sp[g * 128 + t];
        const float u = bf2f(F.proj[(size_t)m * PW + PC_UB + ch]), z = bf2f(F.proj[(size_t)m * PW + PC_ZB + ch]);
        F.concat[(size_t)m * MIXW + 1024 + ch] = (bf16)f2bf(u * s * silu(z));
    }
}
__device__ __forceinline__ void naive_gateA(Frame& F) {
    const int gw = F.vcu * NWAVES + F.wave, NGW = F.G * NWAVES, lane = F.lane;
    for (int it = gw; it < M * 8; it += NGW) {
        const int m = it >> 3, h = it & 7;
        const float* p = F.oraw + (size_t)m * 1024 + h * 128 + 2 * lane;
        const float a = p[0], b = p[1];
        const float sc = rsqrtf(wave_sum(a * a + b * b) * (1.f / 128.f) + EPS);
        const unsigned z = *(const unsigned*)(F.proj + (size_t)m * PW + PC_ZA + h * 128 + 2 * lane);
        *(unsigned*)(F.concat + (size_t)m * MIXW + h * 128 + 2 * lane) = pk2(a * sc * F.head_w[2 * lane] * silu(bflo(z)), b * sc * F.head_w[2 * lane + 1] * silu(bfhi(z)));
    }
}
__device__ __forceinline__ void p5_final(Frame& F) {
    const int gw = F.vcu * NWAVES + F.wave, NGW = F.G * NWAVES, lane = F.lane;
    for (int m = gw; m < M; m += NGW) {
        const float part = (lane < 32) ? F.rowss[(size_t)m * 32 + lane] : 0.f;
        const float rs = rsqrtf(wave_sum(part) * (1.f / DM) + EPS);
        GAS f32x4* o = (GAS f32x4*)(F.out + (size_t)m * DM) + lane;
#pragma unroll
        for (int j = 0; j < 8; ++j) { const f32x4 w = ((const GAS f32x4*)F.fin_w)[64 * j + lane]; f32x4 v = o[64 * j]; v = v * rs * w; o[64 * j] = v; }
    }
}


typedef short bf16x8 __attribute__((ext_vector_type(8)));
typedef float f32x16 __attribute__((ext_vector_type(16)));
typedef float f32x2 __attribute__((ext_vector_type(2)));
typedef __bf16 bf16x2v __attribute__((ext_vector_type(2)));
#define MFMA32(a, b, c) __builtin_amdgcn_mfma_f32_32x32x16_bf16((a), (b), (c), 0, 0, 0)
__device__ __forceinline__ unsigned pkc(float a, float b) { f32x2 v = {a, b}; bf16x2v r = __builtin_convertvector(v, bf16x2v); return __builtin_bit_cast(unsigned, r); }
__device__ __forceinline__ int crow(int reg, int h) { return (reg & 3) + 8 * (reg >> 2) + 4 * h; }
__device__ __forceinline__ bf16x8 pack_frag(const f32x16& x, int s, float sc) {
    v4u p; p.x = pkc(x[8 * s] * sc, x[8 * s + 1] * sc); p.y = pkc(x[8 * s + 2] * sc, x[8 * s + 3] * sc); p.z = pkc(x[8 * s + 4] * sc, x[8 * s + 5] * sc); p.w = pkc(x[8 * s + 6] * sc, x[8 * s + 7] * sc);
    return __builtin_bit_cast(bf16x8, p);
}
__device__ __forceinline__ f32x16 zero16() { f32x16 z; for (int i = 0; i < 16; ++i) z[i] = 0.f; return z; }

constexpr size_t WS_UBUF = 40 * MiB;
constexpr size_t WS_WFRAG = 400 * MiB;
constexpr size_t WS_QFRAG = 432 * MiB;
constexpr size_t WS_KFRAG = 464 * MiB;
constexpr size_t WS_AFRAG = 496 * MiB;
constexpr size_t WS_GAMMA = 394 * MiB + 512 * 1024;

constexpr int AL_KL = 0, AL_QL = 17408, AL_KT = 34816, AL_VT = 53248, AL_LF = 71680, AL_TF = 89088, AL_TB = 106496, AL_TG = 115712, AL_GC = 124928, AL_BETA = 125184, AL_DEC = 125440, AL_EG = 125696, AL_PF = 0;
constexpr int KLS = 136, KTS = 72, LFS = 68;

__device__ __forceinline__ void a_local_unit(Frame& F, int b, int h, int n) {
    LAS unsigned char* L = (LAS unsigned char*)F.lds;
    LAS bf16* KL = (LAS bf16*)(L + AL_KL); LAS bf16* QL = (LAS bf16*)(L + AL_QL); LAS bf16* KT = (LAS bf16*)(L + AL_KT); LAS bf16* VT = (LAS bf16*)(L + AL_VT);
    LAS float* LF = (LAS float*)(L + AL_LF); LAS float* TF = (LAS float*)(L + AL_TF); LAS float* PF = (LAS float*)(L + AL_PF);
    LAS bf16* TB = (LAS bf16*)(L + AL_TB); LAS bf16* TG = (LAS bf16*)(L + AL_TG);
    LAS float* GC = (LAS float*)(L + AL_GC); LAS float* BETA = (LAS float*)(L + AL_BETA); LAS float* DEC = (LAS float*)(L + AL_DEC); LAS float* EG = (LAS float*)(L + AL_EG);
    const int tid = F.tid, lane = F.lane, w = F.wave, r = lane & 31, hh = lane >> 5;
    const int t0 = n * 64; const size_t m0 = (size_t)b * SEQ + t0; const int unit = (b * 8 + h) * 64 + n;
    const float qscale = 0.08838834764831845f;
    for (int i = tid; i < 64 * LFS; i += NWAVES * 64) TF[i] = 0.f;
    if (w == 0) {
        const size_t m = m0 + lane;
        const float beta = sigmoidf_(F.ab[m * 16 + h]);
        const float g = -__expf(F.a_log[h]) * softplus_(F.ab[m * 16 + 8 + h] + F.dt_bias[h]);
        float gc = g;
#pragma unroll
        for (int o = 1; o < 64; o <<= 1) { const float t = __shfl_up(gc, o); if (lane >= o) gc += t; }
        const float glast = __shfl(gc, 63);
        GC[lane] = gc; BETA[lane] = beta; DEC[lane] = __expf(glast - gc); EG[lane] = __expf(gc);
        if (lane == 63) ((float*)(F.ws + WS_GAMMA))[unit] = __expf(glast);
    }
    {
        unsigned raw[3][11];
#pragma unroll
        for (int p = 0; p < 3; ++p)
#pragma unroll
            for (int i = 0; i < 11; ++i) { const int tt = t0 + 8 * w - 3 + i;
                raw[p][i] = (tt >= 0) ? *(const unsigned*)(F.proj + (m0 + 8 * w - 3 + i) * PW + p * 1024 + h * 128 + 2 * lane) : 0u; }
        float val[3][8][2];
#pragma unroll
        for (int p = 0; p < 3; ++p) {
            float cw0[4], cw1[4];
#pragma unroll
            for (int j = 0; j < 4; ++j) { const f32x2 c2 = *(const f32x2*)(F.conv_w + j * 3072 + p * 1024 + h * 128 + 2 * lane); cw0[j] = c2.x; cw1[j] = c2.y; }
#pragma unroll
            for (int i = 0; i < 8; ++i) { float s0 = 0.f, s1 = 0.f;
#pragma unroll
                for (int j = 0; j < 4; ++j) { s0 += cw0[j] * bflo(raw[p][i + j]); s1 += cw1[j] * bfhi(raw[p][i + j]); }
                s0 = silu(s0); s1 = silu(s1);
                if (p < 2) { const float sc = rsqrtf(wave_sum(s0 * s0 + s1 * s1) + EPS); s0 *= sc; s1 *= sc; }
                val[p][i][0] = s0; val[p][i][1] = s1; }
        }
#pragma unroll
        for (int i = 0; i < 8; ++i) {
            *(LAS unsigned*)(QL + (8 * w + i) * KLS + 2 * lane) = pkc(val[0][i][0], val[0][i][1]);
            *(LAS unsigned*)(KL + (8 * w + i) * KLS + 2 * lane) = pkc(val[1][i][0], val[1][i][1]);
        }
#pragma unroll
        for (int e = 0; e < 2; ++e) {
            v4u kk, vv;
            kk.x = pkc(val[1][0][e], val[1][1][e]); kk.y = pkc(val[1][2][e], val[1][3][e]); kk.z = pkc(val[1][4][e], val[1][5][e]); kk.w = pkc(val[1][6][e], val[1][7][e]);
            vv.x = pkc(val[2][0][e], val[2][1][e]); vv.y = pkc(val[2][2][e], val[2][3][e]); vv.z = pkc(val[2][4][e], val[2][5][e]); vv.w = pkc(val[2][6][e], val[2][7][e]);
            *(LAS v4u*)(KT + (2 * lane + e) * KTS + 8 * w) = kk;
            *(LAS v4u*)(VT + (2 * lane + e) * KTS + 8 * w) = vv;
        }
    }
    __syncthreads();
#pragma unroll
    for (int i = 0; i < 2; ++i) {
        const int f = w + 8 * i;
        { const int ct = f >> 3, dt = (f & 7) >> 1, s = f & 1; const int c = 32 * ct + r, d0 = 32 * dt + 16 * s + 4 * hh;
          const v2u lo = *(const LAS v2u*)(QL + c * KLS + d0), hi = *(const LAS v2u*)(QL + c * KLS + d0 + 8);
          const float sc = qscale * EG[c];
          v4u o; o.x = pkc(bflo(lo.x) * sc, bfhi(lo.x) * sc); o.y = pkc(bflo(lo.y) * sc, bfhi(lo.y) * sc); o.z = pkc(bflo(hi.x) * sc, bfhi(hi.x) * sc); o.w = pkc(bflo(hi.y) * sc, bfhi(hi.y) * sc);
          *(GAS v4u*)(F.ws + WS_QFRAG + (((size_t)unit * 16 + f) * 64 + lane) * 16) = o; }
        { const int dt = f >> 2, ct = (f & 3) >> 1, s = f & 1; const int d = 32 * dt + r, c0 = 32 * ct + 16 * s + 4 * hh;
          const v2u lo = *(const LAS v2u*)(KT + d * KTS + c0), hi = *(const LAS v2u*)(KT + d * KTS + c0 + 8);
          const f32x4 d0 = *(const LAS f32x4*)(DEC + c0), d1 = *(const LAS f32x4*)(DEC + c0 + 8);
          v4u o; o.x = pkc(bflo(lo.x) * d0.x, bfhi(lo.x) * d0.y); o.y = pkc(bflo(lo.y) * d0.z, bfhi(lo.y) * d0.w); o.z = pkc(bflo(hi.x) * d1.x, bfhi(hi.x) * d1.y); o.w = pkc(bflo(hi.y) * d1.z, bfhi(hi.y) * d1.w);
          *(GAS v4u*)(F.ws + WS_KFRAG + (((size_t)unit * 16 + f) * 64 + lane) * 16) = o; }
    }
    if (w < 6) {
        const int ta = (w == 0) ? 0 : (w == 1) ? 1 : (w == 2) ? 1 : (w == 3) ? 0 : (w == 4) ? 0 : 1;
        const int tb = (w == 0) ? 0 : (w == 1) ? 0 : (w == 2) ? 1 : (w == 3) ? 0 : (w == 4) ? 1 : 1;
        const LAS bf16* Bsrc = (w < 3) ? KL : QL;
        f32x16 acc = zero16();
#pragma unroll
        for (int s = 0; s < 8; ++s) {
            const bf16x8 a = *(const LAS bf16x8*)(KL + (32 * ta + r) * KLS + 16 * s + 8 * hh);
            const bf16x8 bb = *(const LAS bf16x8*)(Bsrc + (32 * tb + r) * KLS + 16 * s + 8 * hh);
            acc = MFMA32(a, bb, acc);
        }
        if (w < 3) {
            const int cp = 32 * tb + r; const float gcp = GC[cp];
#pragma unroll
            for (int i = 0; i < 16; ++i) { const int c = 32 * ta + crow(i, hh);
                LF[c * LFS + cp] = (c > cp) ? BETA[c] * acc[i] * __expf(GC[c] - gcp) : 0.f; }
        } else {
            const int c = 32 * tb + r; const float gcc = GC[c];
            f32x16 av;
#pragma unroll
            for (int i = 0; i < 16; ++i) { const int cp = 32 * ta + crow(i, hh); av[i] = (c >= cp) ? qscale * acc[i] * __expf(gcc - GC[cp]) : 0.f; }
            const int idx = w - 3;
#pragma unroll
            for (int s = 0; s < 2; ++s) { const bf16x8 fr = pack_frag(av, s, 1.f);
                *(GAS bf16x8*)(F.ws + WS_AFRAG + (((size_t)unit * 6 + idx * 2 + s) * 64 + lane) * 16) = fr; }
        }
    }
    __syncthreads();
    if (tid < 64) {
        const int blk = tid >> 4, col = tid & 15; float x[16];
#pragma unroll
        for (int i = 0; i < 16; ++i) { float s = (i == col) ? 1.f : 0.f;
#pragma unroll
            for (int j = 0; j < i; ++j) s -= LF[(16 * blk + i) * LFS + 16 * blk + j] * x[j];
            x[i] = s; }
#pragma unroll
        for (int i = 0; i < 16; ++i) TF[(16 * blk + i) * LFS + 16 * blk + col] = x[i];
    }
    __syncthreads();
    {
        const int p = tid >> 8, i = (tid >> 4) & 15, l = tid & 15; float s = 0.f;
#pragma unroll
        for (int k = 0; k < 16; ++k) s += LF[(32 * p + 16 + i) * LFS + 32 * p + k] * TF[(32 * p + k) * LFS + 32 * p + l];
        PF[(32 * p + 16 + i) * LFS + 32 * p + l] = s;
        __syncthreads();
        float t = 0.f;
#pragma unroll
        for (int j = 0; j < 16; ++j) t += TF[(32 * p + 16 + i) * LFS + 32 * p + 16 + j] * PF[(32 * p + 16 + j) * LFS + 32 * p + l];
        TF[(32 * p + 16 + i) * LFS + 32 * p + l] = -t;
    }
    __syncthreads();
    {
#pragma unroll
        for (int e = 0; e < 2; ++e) { const int o = tid + 512 * e, i = o >> 5, l = o & 31; float s = 0.f;
#pragma unroll 8
            for (int k = 0; k < 32; ++k) s += LF[(32 + i) * LFS + k] * TF[k * LFS + l];
            PF[(32 + i) * LFS + l] = s; }
        __syncthreads();
        float tv[2];
#pragma unroll
        for (int e = 0; e < 2; ++e) { const int o = tid + 512 * e, i = o >> 5, l = o & 31; float t = 0.f;
#pragma unroll 8
            for (int j = 0; j < 32; ++j) t += TF[(32 + i) * LFS + 32 + j] * PF[(32 + j) * LFS + l];
            tv[e] = -t; }
#pragma unroll
        for (int e = 0; e < 2; ++e) { const int o = tid + 512 * e, i = o >> 5, l = o & 31; TF[(32 + i) * LFS + l] = tv[e]; }
    }
    __syncthreads();
    {
        const int c = tid >> 3, c0 = (tid & 7) * 8; float tb[8], tg[8];
#pragma unroll
        for (int j = 0; j < 8; ++j) { const float t = TF[c * LFS + c0 + j] * BETA[c0 + j]; tb[j] = t; tg[j] = t * EG[c0 + j]; }
        v4u a, g; a.x = pkc(tb[0], tb[1]); a.y = pkc(tb[2], tb[3]); a.z = pkc(tb[4], tb[5]); a.w = pkc(tb[6], tb[7]);
        g.x = pkc(tg[0], tg[1]); g.y = pkc(tg[2], tg[3]); g.z = pkc(tg[4], tg[5]); g.w = pkc(tg[6], tg[7]);
        *(LAS v4u*)(TB + c * KTS + c0) = a; *(LAS v4u*)(TG + c * KTS + c0) = g;
    }
    __syncthreads();
    {
        const int ct = w & 1, et = w >> 1; f32x16 acc = zero16();
#pragma unroll
        for (int s = 0; s < 4; ++s) {
            const bf16x8 a = *(const LAS bf16x8*)(TB + (32 * ct + r) * KTS + 16 * s + 8 * hh);
            const bf16x8 bb = *(const LAS bf16x8*)(VT + (32 * et + r) * KTS + 16 * s + 8 * hh);
            acc = MFMA32(a, bb, acc);
        }
        GAS f32x4* up = (GAS f32x4*)(F.ws + WS_UBUF + ((((size_t)unit * 4 + et) * 2 + ct) * 64 + lane) * 64);
        up[0] = (f32x4){acc[0], acc[1], acc[2], acc[3]}; up[1] = (f32x4){acc[4], acc[5], acc[6], acc[7]};
        up[2] = (f32x4){acc[8], acc[9], acc[10], acc[11]}; up[3] = (f32x4){acc[12], acc[13], acc[14], acc[15]};
    }
    {
        const int dt = w & 3, ct = w >> 2; f32x16 acc = zero16();
#pragma unroll
        for (int s = 0; s < 4; ++s) {
            const bf16x8 a = *(const LAS bf16x8*)(KT + (32 * dt + r) * KTS + 16 * s + 8 * hh);
            const bf16x8 bb = *(const LAS bf16x8*)(TG + (32 * ct + r) * KTS + 16 * s + 8 * hh);
            acc = MFMA32(a, bb, acc);
        }
#pragma unroll
        for (int s = 0; s < 2; ++s) { const bf16x8 fr = pack_frag(acc, s, -1.f);
            *(GAS bf16x8*)(F.ws + WS_WFRAG + (((size_t)unit * 16 + ct * 8 + dt * 2 + s) * 64 + lane) * 16) = fr; }
    }
    __syncthreads();
}

constexpr int SC_OPB = 55296;
constexpr int SC_OP0 = 0, SC_OBUF = 2 * SC_OPB;
constexpr int OBS = 136;
__device__ __forceinline__ void scan_finish_chunk(Frame& F, LAS unsigned char* L, int b, int h, int nprev, int oc, int oq) {
    const LAS bf16* ob = (const LAS bf16*)(L + SC_OBUF + (nprev & 1) * (64 * OBS * 2)) + oc * OBS + 32 * oq;
    const size_t m = (size_t)b * SEQ + (size_t)nprev * 64 + oc;
    v4u ov[4], zv[4];
#pragma unroll
    for (int i = 0; i < 4; ++i) { ov[i] = *(const LAS v4u*)(ob + 8 * i); zv[i] = *(const GAS v4u*)(F.proj + m * PW + PC_ZA + h * 128 + 32 * oq + 8 * i); }
    float ss = 0.f;
#pragma unroll
    for (int i = 0; i < 4; ++i) { const unsigned ww[4] = {ov[i].x, ov[i].y, ov[i].z, ov[i].w};
#pragma unroll
        for (int j = 0; j < 4; ++j) { const float a = bflo(ww[j]), c = bfhi(ww[j]); ss += a * a + c * c; } }
    ss += __shfl_xor(ss, 1); ss += __shfl_xor(ss, 2);
    const float rs = rsqrtf(ss * (1.f / 128.f) + EPS);
#pragma unroll
    for (int i = 0; i < 4; ++i) { const unsigned ww[4] = {ov[i].x, ov[i].y, ov[i].z, ov[i].w}; const unsigned zz[4] = {zv[i].x, zv[i].y, zv[i].z, zv[i].w}; unsigned oo[4];
        const f32x4 h0 = *(const GAS f32x4*)(F.head_w + 32 * oq + 8 * i), h1 = *(const GAS f32x4*)(F.head_w + 32 * oq + 8 * i + 4);
        const float hwv[8] = {h0.x, h0.y, h0.z, h0.w, h1.x, h1.y, h1.z, h1.w};
#pragma unroll
        for (int j = 0; j < 4; ++j) oo[j] = pkc(bflo(ww[j]) * rs * hwv[2 * j] * silu(bflo(zz[j])), bfhi(ww[j]) * rs * hwv[2 * j + 1] * silu(bfhi(zz[j])));
        *(GAS v4u*)(F.concat + m * MIXW + h * 128 + 32 * oq + 8 * i) = (v4u){oo[0], oo[1], oo[2], oo[3]}; }
}
__device__ __forceinline__ void scan_head(Frame& F, int b, int h) {
    LAS unsigned char* L = (LAS unsigned char*)F.lds;
    const int tid = F.tid, lane = F.lane, w = F.wave, r = lane & 31, hh = lane >> 5;
    const int unit0 = (b * 8 + h) * 64;
    if (w < 4) {
        f32x16 S[4]; bf16x8 Sb[4][2];
#pragma unroll
        for (int dt = 0; dt < 4; ++dt) { S[dt] = zero16();
#pragma unroll
            for (int s = 0; s < 2; ++s) Sb[dt][s] = (bf16x8){0, 0, 0, 0, 0, 0, 0, 0}; }
        __syncthreads();
        for (int n = 0; n < 64; ++n) {
            const int unit = unit0 + n;
            const LAS unsigned char* ops = L + SC_OP0 + (n & 1) * SC_OPB;
            const float gamma = ((const float*)(F.ws + WS_GAMMA))[unit];
            f32x16 U[2];
#pragma unroll
            for (int ct = 0; ct < 2; ++ct) { const GAS f32x4* up = (const GAS f32x4*)(F.ws + WS_UBUF + ((((size_t)unit * 4 + w) * 2 + ct) * 64 + lane) * 64);
                const f32x4 a = up[0], b2 = up[1], c2 = up[2], d2 = up[3];
                U[ct] = (f32x16){a.x, a.y, a.z, a.w, b2.x, b2.y, b2.z, b2.w, c2.x, c2.y, c2.z, c2.w, d2.x, d2.y, d2.z, d2.w}; }
            f32x16 O[2], R[2];
#pragma unroll
            for (int ct = 0; ct < 2; ++ct) { O[ct] = zero16(); R[ct] = zero16(); }
#pragma unroll
            for (int ct = 0; ct < 2; ++ct)
#pragma unroll
                for (int dt = 0; dt < 4; ++dt)
#pragma unroll
                    for (int s = 0; s < 2; ++s) {
                        const bf16x8 qa = *(const LAS bf16x8*)(ops + 16384 + (ct * 8 + dt * 2 + s) * 1024 + lane * 16);
                        O[ct] = MFMA32(qa, Sb[dt][s], O[ct]);
                        const bf16x8 wa = *(const LAS bf16x8*)(ops + (ct * 8 + dt * 2 + s) * 1024 + lane * 16);
                        R[ct] = MFMA32(wa, Sb[dt][s], R[ct]);
                    }
            bf16x8 Vb[2][2];
#pragma unroll
            for (int ct = 0; ct < 2; ++ct) { R[ct] = R[ct] + U[ct];
#pragma unroll
                for (int s = 0; s < 2; ++s) Vb[ct][s] = pack_frag(R[ct], s, 1.f); }
#pragma unroll
            for (int s = 0; s < 2; ++s) {
                const bf16x8 a0 = *(const LAS bf16x8*)(ops + 49152 + (0 * 2 + s) * 1024 + lane * 16);
                O[0] = MFMA32(a0, Vb[0][s], O[0]);
                const bf16x8 a1 = *(const LAS bf16x8*)(ops + 49152 + (1 * 2 + s) * 1024 + lane * 16);
                O[1] = MFMA32(a1, Vb[0][s], O[1]);
                const bf16x8 a2 = *(const LAS bf16x8*)(ops + 49152 + (2 * 2 + s) * 1024 + lane * 16);
                O[1] = MFMA32(a2, Vb[1][s], O[1]);
            }
#pragma unroll
            for (int dt = 0; dt < 4; ++dt) { S[dt] = S[dt] * gamma;
#pragma unroll
                for (int ct = 0; ct < 2; ++ct)
#pragma unroll
                    for (int s = 0; s < 2; ++s) {
                        const bf16x8 ka = *(const LAS bf16x8*)(ops + 32768 + (dt * 4 + ct * 2 + s) * 1024 + lane * 16);
                        S[dt] = MFMA32(ka, Vb[ct][s], S[dt]);
                    }
#pragma unroll
                for (int s = 0; s < 2; ++s) Sb[dt][s] = pack_frag(S[dt], s, 1.f); }
            LAS bf16* ob = (LAS bf16*)(L + SC_OBUF + (n & 1) * (64 * OBS * 2));
#pragma unroll
            for (int ct = 0; ct < 2; ++ct)
#pragma unroll
                for (int i = 0; i < 16; ++i) ob[(32 * ct + crow(i, hh)) * OBS + 32 * w + r] = (bf16)(pkc(O[ct][i], 0.f) & 0xffffu);
            __syncthreads();
        }
        __syncthreads();
    } else {
        const int ltid = tid - 256;
        const int oc = (ltid >> 2) & 63, oq = ltid & 3;
        v4u pre[14];
#define SC_ISSUE(u) do { \
        const GAS v4u* gw_ = (const GAS v4u*)(F.ws + WS_WFRAG + (size_t)(u) * 16384); const GAS v4u* gq_ = (const GAS v4u*)(F.ws + WS_QFRAG + (size_t)(u) * 16384); \
        const GAS v4u* gk_ = (const GAS v4u*)(F.ws + WS_KFRAG + (size_t)(u) * 16384); const GAS v4u* ga_ = (const GAS v4u*)(F.ws + WS_AFRAG + (size_t)(u) * 6144); \
        _Pragma("unroll") for (int i_ = 0; i_ < 4; ++i_) { pre[i_] = gw_[ltid + 256 * i_]; pre[4 + i_] = gq_[ltid + 256 * i_]; pre[8 + i_] = gk_[ltid + 256 * i_]; } \
        pre[12] = ga_[ltid]; pre[13] = (ltid < 128) ? ga_[256 + ltid] : (v4u){0u, 0u, 0u, 0u}; } while (0)
#define SC_COMMIT(bufi) do { LAS v4u* d_ = (LAS v4u*)(L + SC_OP0 + (bufi) * SC_OPB); \
        _Pragma("unroll") for (int i_ = 0; i_ < 13; ++i_) d_[ltid + 256 * i_] = pre[i_]; \
        if (ltid < 128) d_[ltid + 256 * 13] = pre[13]; } while (0)
        SC_ISSUE(unit0); SC_COMMIT(0);
        __syncthreads();
        for (int n = 0; n < 64; ++n) {
            if (n + 1 < 64) SC_ISSUE(unit0 + n + 1);
            if (n >= 1) scan_finish_chunk(F, L, b, h, n - 1, oc, oq);
            if (n + 1 < 64) SC_COMMIT((n + 1) & 1);
            __syncthreads();
        }
        scan_finish_chunk(F, L, b, h, 63, oc, oq);
        __syncthreads();
#undef SC_ISSUE
#undef SC_COMMIT
    }
}

constexpr int BU_MU = 0, BU_RS = 512, BU_VNT = 1024, VNS = 136;
__device__ __forceinline__ void b_unit(Frame& F, int b, int nchunk, int ghalf) {
    LAS unsigned char* L = (LAS unsigned char*)F.lds;
    LAS float* MU = (LAS float*)(L + BU_MU); LAS float* RS = (LAS float*)(L + BU_RS);
    const int tid = F.tid, lane = F.lane, w = F.wave, r = lane & 31, hh = lane >> 5;
    const size_t m0 = (size_t)b * SEQ + (size_t)nchunk * 128;
#pragma unroll 4
    for (int i = 0; i < 16; ++i) {
        const int s = 16 * w + i;
        const GAS v4u* p = (const GAS v4u*)(F.proj + (m0 + s) * PW + PC_VB + 16 * lane);
        const v4u a = p[0], c = p[1]; const unsigned ww[8] = {a.x, a.y, a.z, a.w, c.x, c.y, c.z, c.w};
        float v[16]; float sm = 0.f;
#pragma unroll
        for (int j = 0; j < 8; ++j) { v[2 * j] = bflo(ww[j]); v[2 * j + 1] = bfhi(ww[j]); sm += v[2 * j] + v[2 * j + 1]; }
        const float mu = wave_sum(sm) * (1.f / 1024.f); float q = 0.f;
#pragma unroll
        for (int j = 0; j < 16; ++j) { const float d = v[j] - mu; q += d * d; }
        const float rs = rsqrtf(wave_sum(q) * (1.f / 1024.f) + EPS);
        if (lane == 0) { MU[s] = mu; RS[s] = rs; }
    }
    __syncthreads();
    for (int gi = 0; gi < 4; ++gi) {
        const int g = ghalf * 4 + gi;
        LAS bf16* VNT = (LAS bf16*)(L + BU_VNT + (gi & 1) * (128 * VNS * 2));
        {
            const int s = tid & 127; const float mu = MU[s], rs = RS[s];
#pragma unroll
            for (int i = 0; i < 4; ++i) { const int cc = (tid >> 7) + 4 * i;
                const v4u raw = *(const GAS v4u*)(F.proj + (m0 + s) * PW + PC_VB + g * 128 + 8 * cc);
                const f32x4 w0 = *(const GAS f32x4*)(F.ln_w + g * 128 + 8 * cc), w1 = *(const GAS f32x4*)(F.ln_w + g * 128 + 8 * cc + 4);
                const f32x4 b0 = *(const GAS f32x4*)(F.ln_b + g * 128 + 8 * cc), b1 = *(const GAS f32x4*)(F.ln_b + g * 128 + 8 * cc + 4);
                const unsigned ww[4] = {raw.x, raw.y, raw.z, raw.w}; const float lw[8] = {w0.x, w0.y, w0.z, w0.w, w1.x, w1.y, w1.z, w1.w}; const float lb[8] = {b0.x, b0.y, b0.z, b0.w, b1.x, b1.y, b1.z, b1.w};
#pragma unroll
                for (int j = 0; j < 4; ++j) {
                    const float v0 = (bflo(ww[j]) - mu) * rs * lw[2 * j] + lb[2 * j], v1 = (bfhi(ww[j]) - mu) * rs * lw[2 * j + 1] + lb[2 * j + 1];
                    const unsigned pk = pkc(v0, v1);
                    VNT[(8 * cc + 2 * j) * VNS + s] = (bf16)(pk & 0xffffu); VNT[(8 * cc + 2 * j + 1) * VNS + s] = (bf16)(pk >> 16); }
            }
        }
        __syncthreads();
        {
            const int tt = w >> 1, cc0 = 2 * (w & 1);
            f32x16 acc0 = zero16(), acc1 = zero16();
            const int t = 32 * tt + r;
            const float* wrow = F.w_sp + ((size_t)g * 128 + t) * 128;
            for (int ks = 0; ks < 2 * tt + 2; ++ks) {
                const int s0 = 16 * ks + 8 * hh;
                const f32x4 wa = *(const GAS f32x4*)(wrow + s0), wb = *(const GAS f32x4*)(wrow + s0 + 4);
                const float wv[8] = {wa.x, wa.y, wa.z, wa.w, wb.x, wb.y, wb.z, wb.w}; float wm[8];
#pragma unroll
                for (int j = 0; j < 8; ++j) wm[j] = (s0 + j <= t) ? wv[j] : 0.f;
                v4u ap; ap.x = pkc(wm[0], wm[1]); ap.y = pkc(wm[2], wm[3]); ap.z = pkc(wm[4], wm[5]); ap.w = pkc(wm[6], wm[7]);
                const bf16x8 a = __builtin_bit_cast(bf16x8, ap);
                const bf16x8 b0 = *(const LAS bf16x8*)(VNT + (32 * cc0 + r) * VNS + 16 * ks + 8 * hh);
                const bf16x8 b1 = *(const LAS bf16x8*)(VNT + (32 * (cc0 + 1) + r) * VNS + 16 * ks + 8 * hh);
                acc0 = MFMA32(a, b0, acc0); acc1 = MFMA32(a, b1, acc1);
            }
#pragma unroll
            for (int e = 0; e < 2; ++e)
#pragma unroll
                for (int i = 0; i < 16; ++i) {
                    const int to = 32 * tt + crow(i, hh); const int ch = g * 128 + 32 * (cc0 + e) + r; const size_t m = m0 + to;
                    const float sv = (e ? acc1[i] : acc0[i]) + F.b_sp[g * 128 + to];
                    const float u = bf2f(F.proj[m * PW + PC_UB + ch]), z = bf2f(F.proj[m * PW + PC_ZB + ch]);
                    F.concat[m * MIXW + 1024 + ch] = (bf16)(pkc(u * sv * silu(z), 0.f) & 0xffffu);
                }
        }
    }
    __syncthreads();
}

#ifndef A_NEW
#define A_NEW 1
#endif
#ifndef B_NEW
#define B_NEW 1
#endif
struct Args { const float* in[13]; float* out; unsigned char* ws; };
__global__ void __launch_bounds__(NWAVES * 64, 2) fwd_kernel(Args args) {
    extern __shared__ __attribute__((aligned(16))) unsigned char lds[];
    Frame F;
    F.lds = lds;
    F.tid = threadIdx.x; F.lane = F.tid & 63; F.wave = __builtin_amdgcn_readfirstlane(F.tid >> 6);
    F.G = gridDim.x; { const int bx = blockIdx.x; F.vcu = (F.G % 8 == 0) ? (bx % 8) * (F.G / 8) + bx / 8 : bx; }
    unsigned char* ws = args.ws; F.ws = ws;
    F.x = args.in[0]; F.norm_w = args.in[1]; F.w_in = args.in[2]; F.conv_w = args.in[3]; F.a_log = args.in[4]; F.dt_bias = args.in[5]; F.head_w = args.in[6];
    F.ln_w = args.in[7]; F.ln_b = args.in[8]; F.w_sp = args.in[9]; F.b_sp = args.in[10]; F.w_out = args.in[11]; F.fin_w = args.in[12]; F.out = args.out;
    F.Wt1 = (bf16*)(ws + WS_WT1); F.Wt2 = (bf16*)(ws + WS_WT2); F.XN = (bf16*)(ws + WS_XN); F.proj = (bf16*)(ws + WS_PROJ); F.concat = (bf16*)(ws + WS_CONCAT); F.act = (bf16*)(ws + WS_ACT);
    F.ab = (float*)(ws + WS_AB); F.gates = (float*)(ws + WS_GATES); F.lnst = (float*)(ws + WS_LNST); F.rowss = (float*)(ws + WS_ROWSS); F.oraw = (float*)(ws + WS_ORAW);
    LAS unsigned char* ldsl = (LAS unsigned char*)lds;
    for (int u = F.tid; u < (LDS_BYTES - LDSCTL_OFF) / 4; u += NWAVES * 64) ((LAS unsigned*)(ldsl + LDSCTL_OFF))[u] = 0u;
    __syncthreads();
    volatile LAS unsigned* MISC = (volatile LAS unsigned*)(ldsl + MISC_OFF);
    XcdBarrier bar = xcd_barrier_post((unsigned*)(ws + WS_CTL) + CW_BAR, MISC + 8);

    p0_prologue(F);
    xcd_barrier(bar);
    {
        pg8::Gemm g{F.XN, F.Wt1, M, PW, DM}; pg8::StaticOrder S; S.init(M, PW, F.G, (int)blockIdx.x);
        pg8::EpiBf16 E{F.proj, PW};
        pg8::gemm_phase<pg8::EpiBf16, pg8::StaticOrder, true, true>(ldsl + RING_OFF, g, S, E);
    }
    xcd_barrier(bar);
#if A_NEW
    for (int u = F.vcu; u < 2048; u += F.G) a_local_unit(F, u >> 9, (u >> 6) & 7, u & 63);
#else
    naive_conv_gates(F);
#endif
#if !B_NEW
    naive_lnst(F);
#endif
    xcd_barrier(bar);
    if (blockIdx.x < 32) {
#if A_NEW
        scan_head(F, blockIdx.x >> 3, blockIdx.x & 7);
#else
        naive_scan(F, blockIdx.x >> 3, blockIdx.x & 7);
#endif
    } else {
#if B_NEW
        for (int ub = blockIdx.x - 32; ub < 256; ub += F.G - 32) b_unit(F, ub >> 6, (ub >> 1) & 31, ub & 1);
#else
        naive_sgu(F, 32);
#endif
    }
    xcd_barrier(bar);
#if !A_NEW
    naive_gateA(F);
    xcd_barrier(bar);
#endif
    {
        pg8::Gemm g{F.concat, F.Wt2, M, DM, MIXW}; pg8::StaticOrder S; S.init(M, DM, F.G, (int)blockIdx.x);
        pg8::EpiResid E{F.x, F.out, DM, F.rowss};
        pg8::gemm_phase<pg8::EpiResid, pg8::StaticOrder, true, true>(ldsl + RING_OFF, g, S, E);
    }
    xcd_barrier(bar);
    p5_final(F);
}

extern "C" void kernel_launch(void* const* d_in, const int* in_sizes, int n_in, void* d_out, int out_size, void* d_ws, size_t ws_size, hipStream_t stream) {
    static int grid = 0;
    if (grid == 0) {
        int dev = 0, cus = 0;
        if (hipGetDevice(&dev) != hipSuccess || hipDeviceGetAttribute(&cus, hipDeviceAttributeMultiprocessorCount, dev) != hipSuccess) { fprintf(stderr, "kernel_launch: device query failed\n"); grid = -1; return; }
        if (hipFuncSetAttribute((const void*)fwd_kernel, hipFuncAttributeMaxDynamicSharedMemorySize, LDS_BYTES) != hipSuccess) { fprintf(stderr, "kernel_launch: hipFuncSetAttribute failed\n"); grid = -1; return; }
        int per_cu = 0;
        if (hipOccupancyMaxActiveBlocksPerMultiprocessor(&per_cu, (const void*)fwd_kernel, NWAVES * 64, LDS_BYTES) != hipSuccess || per_cu < 1) fprintf(stderr, "kernel_launch: occupancy query reports %d blocks per CU\n", per_cu);
        (void)hipGetLastError();
        grid = cus;
    }
    if (grid < 0) return;
    (void)hipMemsetAsync((char*)d_ws + WS_CTL, 0, CTL_ZERO_BYTES, stream);
    Args a{};
    for (int i = 0; i < 13; ++i) a.in[i] = (const float*)d_in[i];
    a.out = (float*)d_out; a.ws = (unsigned char*)d_ws;
    hipLaunchKernelGGL(fwd_kernel, dim3(grid), dim3(NWAVES * 64), LDS_BYTES, stream, a);
}
```

```cpp
#include <hip/hip_runtime.h>
#include <cstdio>
#include <cstdint>
namespace pg8 {
#define PG8_LAS __attribute__((address_space(3)))
typedef unsigned short bf16_t;
typedef short bf16x8 __attribute__((ext_vector_type(8)));
typedef float f32x4 __attribute__((ext_vector_type(4)));
typedef unsigned u32x4 __attribute__((ext_vector_type(4)));
constexpr int BM = 256, BK = 64, HALF = 128, HTB = HALF * BK * 2  , STAGE_BYTES = 8 * HTB, NXCD = 8, WGM = 8;

__host__ __device__ __forceinline__ int lds_byte(int r, int c) { const int st = (r >> 4) * 2 + (c >> 5), rr = r & 15, cc = c & 31, ob = rr * 64 + cc * 2; return st * 1024 + (ob ^ (((ob >> 9) & 1) << 5)); }
__host__ __device__ __forceinline__ void stage_rc(int b, int& R, int& C) { const int st = b / 1024, sb = b % 1024, swz = sb ^ (((sb >> 9) & 1) << 5); R = (st >> 1) * 16 + swz / 64; C = (st & 1) * 32 + (swz % 64) / 2; }
__host__ __device__ __forceinline__ int perm32(int rho) { const int n = rho >> 4, i = rho & 15; return 8 * (i >> 2) + 4 * n + (i & 3); }

struct Unit { int pm, pn; };
struct Gemm { const bf16_t* A; const bf16_t* Bt; int M, N, K; };

struct StaticOrder {
    int nM, nN, nwg, G, c;
    __host__ __device__ void init(int M, int N, int G_, int c_) { nM = M / BM; nN = N / BM; nwg = nM * nN; G = G_; c = c_; }
    __host__ __device__ bool next(int i, Unit& u) const {
        const long L = (long)i * G + c; if (L >= nwg) return false;
        int wgid = (int)L; { const int q = nwg / NXCD, r = nwg % NXCD, xcd = wgid % NXCD, off = wgid / NXCD; wgid = (xcd < r ? xcd * (q + 1) : r * (q + 1) + (xcd - r) * q) + off; }
        const int nig = WGM * nN, gid = wgid / nig, fm = gid * WGM, gsz = (nM - fm) < WGM ? (nM - fm) : WGM;
        u.pm = fm + ((wgid % nig) % gsz); u.pn = (wgid % nig) / gsz; return true;
    }
    __device__ __forceinline__ void a_ready(const Unit&) const {}
    __device__ __forceinline__ void done(const Unit&) const {}
};


__device__ __forceinline__ unsigned cvt_pk_bf16(float lo, float hi) { unsigned r; asm volatile("v_cvt_pk_bf16_f32 %0, %1, %2" : "=v"(r) : "v"(lo), "v"(hi)); return r; }
struct EpiBf16 {
    static constexpr bool PERM = true, AFTER_DRAIN = false;
    bf16_t* O; int ldc;
    __device__ __forceinline__ void operator()(const f32x4 (&acc)[2][2][4][2], const Unit& u, int wr, int wc, int fr, int fq) const {
        const int row0 = u.pm * BM + wr * 64 + fr; const int col0 = u.pn * BM + wc * 32 + 8 * fq;
#pragma unroll
        for (int ai = 0; ai < 2; ++ai)
#pragma unroll
            for (int m = 0; m < 4; ++m) { bf16_t* rowp = O + (size_t)(row0 + ai * HALF + m * 16) * ldc + col0;
#pragma unroll
                for (int bj = 0; bj < 2; ++bj) { const f32x4 v0 = acc[ai][bj][m][0], v1 = acc[ai][bj][m][1];
                    u32x4 w; w.x = cvt_pk_bf16(v0[0], v0[1]); w.y = cvt_pk_bf16(v0[2], v0[3]); w.z = cvt_pk_bf16(v1[0], v1[1]); w.w = cvt_pk_bf16(v1[2], v1[3]);
                    *(u32x4*)(rowp + bj * HALF) = w; } }
    }
};
struct EpiResid {
    static constexpr bool PERM = false, AFTER_DRAIN = false;
    const float* base; float* out; int ldc; float* rowss;
    __device__ __forceinline__ void operator()(const f32x4 (&acc)[2][2][4][2], const Unit& u, int wr, int wc, int fr, int fq) const {
        const int row0 = u.pm * BM + wr * 64 + fr, col0 = u.pn * BM + wc * 32 + 4 * fq;
#pragma unroll
        for (int ai = 0; ai < 2; ++ai)
#pragma unroll
            for (int m = 0; m < 4; ++m) { const int row = row0 + ai * HALF + m * 16; const size_t off = (size_t)row * ldc + col0; float ss = 0.f;
#pragma unroll
                for (int bj = 0; bj < 2; ++bj)
#pragma unroll
                    for (int n = 0; n < 2; ++n) { const f32x4 b = *(const f32x4*)(base + off + bj * HALF + n * 16); const f32x4 o = b + acc[ai][bj][m][n];
                        *(f32x4*)(out + off + bj * HALF + n * 16) = o; ss += (o[0] * o[0] + o[1] * o[1]) + (o[2] * o[2] + o[3] * o[3]); }
                ss += __shfl_xor(ss, 16); ss += __shfl_xor(ss, 32);
                if (fq == 0) rowss[(size_t)row * 32 + u.pn * 4 + wc] = ss; }
    }
};

template <class Epi, class Sched, bool ALIGN_EPI = false, bool SP2 = false>
__device__ __forceinline__ void gemm_phase(PG8_LAS unsigned char* lds, const Gemm g, const Sched& S, const Epi& E, const int wave_id) {
    int lane_; asm volatile("v_mbcnt_lo_u32_b32 %0, -1, 0\n\tv_mbcnt_hi_u32_b32 %0, -1, %0" : "=v"(lane_));
    const int wid = wave_id, tid = wid * 64 + lane_, lane = tid & 63, wr = wid >> 2, wc = wid & 3, fr = lane & 15, fq = lane >> 4;
    const int K = g.K, nt = K / BK;
    unsigned voffA[2], voffB[2];
#pragma unroll
    for (int i = 0; i < 2; ++i) { int R, C; stage_rc(tid * 16 + i * 8192, R, C); const int Rb = Epi::PERM ? ((R & ~31) + perm32(R & 31)) : R;
        voffA[i] = (unsigned)(R * K + C) * 2u; voffB[i] = (unsigned)(Rb * K + C) * 2u; }
    const size_t kstep = (size_t)(BK * 2);
    const size_t hstep = (size_t)HALF * K * 2;
    const size_t tstep = 2 * hstep;
    const unsigned ldsw = (unsigned)wid * 1024u;
    const int aoff = lds_byte(wr * 64 + fr, fq * 8), boff = lds_byte(wc * 32 + fr, fq * 8);
#define PG8_SA(b, h) (((b) * 2 + (h)) * HTB)
#define PG8_SB(b, h) ((4 + (b) * 2 + (h)) * HTB)
#define PG8_STAGE(bufoff, gbase, voff) do { _Pragma("unroll") for (int _i = 0; _i < 2; ++_i) \
        __builtin_amdgcn_global_load_lds((const unsigned*)((const char*)(gbase) + (voff)[_i]), (PG8_LAS unsigned*)(lds + (bufoff) + ldsw + _i * 8192), 16, 0, 0); } while (0)
#define PG8_LDA(dst, b, h) do { _Pragma("unroll") for (int m = 0; m < 4; ++m) _Pragma("unroll") for (int k = 0; k < 2; ++k) dst[m][k] = *(const PG8_LAS bf16x8*)(lds + PG8_SA(b, h) + aoff + m * 2048 + k * 1024); } while (0)
#define PG8_LDB(dst, b, h) do { _Pragma("unroll") for (int n = 0; n < 2; ++n) _Pragma("unroll") for (int k = 0; k < 2; ++k) dst[n][k] = *(const PG8_LAS bf16x8*)(lds + PG8_SB(b, h) + boff + n * 2048 + k * 1024); } while (0)
#define PG8_MMA(ai, bj, At, Bt) do { __builtin_amdgcn_s_setprio(1); _Pragma("unroll") for (int m = 0; m < 4; ++m) _Pragma("unroll") for (int n = 0; n < 2; ++n) _Pragma("unroll") for (int k = 0; k < 2; ++k) \
        acc[ai][bj][m][n] = __builtin_amdgcn_mfma_f32_16x16x32_bf16(Bt[n][k], At[m][k], acc[ai][bj][m][n], 0, 0, 0); __builtin_amdgcn_s_setprio(0); } while (0)
#define PG8_WAIT_V(n) asm volatile("s_waitcnt vmcnt(" #n ")" ::: "memory")
#define PG8_WAIT_L(n) asm volatile("s_waitcnt lgkmcnt(" #n ")" ::: "memory")
#define PG8_BAR __builtin_amdgcn_s_barrier()
#define PG8_SCHED __builtin_amdgcn_sched_barrier(0)
    Unit cur, nxt; int ui = 0;
    if (!S.next(0, cur)) return;
    f32x4 acc[2][2][4][2];
#pragma unroll
    for (int a = 0; a < 2; ++a)
#pragma unroll
        for (int b = 0; b < 2; ++b)
#pragma unroll
            for (int m = 0; m < 4; ++m)
#pragma unroll
                for (int n = 0; n < 2; ++n) acc[a][b][m][n] = (f32x4){0.f, 0.f, 0.f, 0.f};
    bf16x8 At[4][2], B0[2][2], B1[2][2];
    const char* cA = (const char*)g.A + (size_t)cur.pm * tstep; const char* cB = (const char*)g.Bt + (size_t)cur.pn * tstep;
    S.a_ready(cur);
    if constexpr (SP2) {
        PG8_STAGE(PG8_SB(0, 0), cB, voffB); PG8_STAGE(PG8_SB(0, 1), cB + hstep, voffB); PG8_STAGE(PG8_SA(0, 0), cA, voffA); PG8_STAGE(PG8_SA(0, 1), cA + hstep, voffA);
        if (wr == 1) PG8_BAR;
        PG8_WAIT_V(2); PG8_BAR;
        PG8_STAGE(PG8_SB(1, 0), cB + kstep, voffB); PG8_STAGE(PG8_SA(1, 0), cA + kstep, voffA); PG8_STAGE(PG8_SB(1, 1), cB + hstep + kstep, voffB);
        PG8_WAIT_V(6); PG8_BAR;
    } else {
        PG8_STAGE(PG8_SB(0, 0), cB, voffB); PG8_STAGE(PG8_SA(0, 0), cA, voffA); PG8_STAGE(PG8_SB(0, 1), cB + hstep, voffB); PG8_STAGE(PG8_SA(0, 1), cA + hstep, voffA);
        if (wr == 1) PG8_BAR;
        PG8_WAIT_V(4); PG8_BAR;
        PG8_STAGE(PG8_SB(1, 0), cB + kstep, voffB); PG8_STAGE(PG8_SA(1, 0), cA + kstep, voffA); PG8_STAGE(PG8_SB(1, 1), cB + hstep + kstep, voffB);
        PG8_WAIT_V(6); PG8_BAR;
    }
    for (;;) {
        const bool has_next = S.next(ui + 1, nxt);
        const char* nA = has_next ? (const char*)g.A + (size_t)nxt.pm * tstep : cA; const char* nB = has_next ? (const char*)g.Bt + (size_t)nxt.pn * tstep : cB;
        for (int t = 0; t < nt; t += 2) {
            const bool last = (t == nt - 2);
            const char* a1 = cA + (size_t)(t + 1) * kstep;
            const char* a2 = last ? nA : cA + (size_t)(t + 2) * kstep; const char* b2 = last ? nB : cB + (size_t)(t + 2) * kstep;
            const char* a3 = a2 + kstep; const char* b3 = b2 + kstep;
            if (last && has_next) S.a_ready(nxt);
            if constexpr (SP2) {
            PG8_LDB(B0, 0, 0); PG8_LDB(B1, 0, 1); PG8_SCHED; PG8_LDA(At, 0, 0); PG8_STAGE(PG8_SA(1, 1), a1 + hstep, voffA);
            PG8_WAIT_V(8); PG8_WAIT_L(0); PG8_BAR; PG8_MMA(0, 0, At, B0); PG8_MMA(0, 1, At, B1); PG8_BAR; PG8_SCHED;
            PG8_LDA(At, 0, 1); PG8_STAGE(PG8_SB(0, 0), b2, voffB); PG8_STAGE(PG8_SB(0, 1), b2 + hstep, voffB); PG8_STAGE(PG8_SA(0, 0), a2, voffA);
            PG8_WAIT_V(8); PG8_WAIT_L(0); PG8_BAR; PG8_MMA(1, 0, At, B0); PG8_MMA(1, 1, At, B1); PG8_BAR; PG8_SCHED;
            PG8_LDB(B0, 1, 0); PG8_LDB(B1, 1, 1); PG8_SCHED; PG8_LDA(At, 1, 0); PG8_STAGE(PG8_SA(0, 1), a2 + hstep, voffA);
            PG8_WAIT_V(8); PG8_WAIT_L(0); PG8_BAR; PG8_MMA(0, 0, At, B0); PG8_MMA(0, 1, At, B1); PG8_BAR; PG8_SCHED;
            PG8_LDA(At, 1, 1); PG8_STAGE(PG8_SB(1, 0), b3, voffB); PG8_STAGE(PG8_SB(1, 1), b3 + hstep, voffB); PG8_STAGE(PG8_SA(1, 0), a3, voffA);
            PG8_WAIT_V(8); PG8_WAIT_L(0); PG8_BAR; PG8_MMA(1, 0, At, B0); PG8_MMA(1, 1, At, B1); PG8_BAR; PG8_SCHED;
            } else {
            PG8_LDB(B0, 0, 0); PG8_SCHED; PG8_LDA(At, 0, 0); PG8_STAGE(PG8_SA(1, 1), a1 + hstep, voffA);
            PG8_WAIT_L(8); PG8_BAR; PG8_WAIT_L(0); PG8_MMA(0, 0, At, B0); PG8_BAR; PG8_SCHED;
            PG8_LDB(B1, 0, 1); PG8_STAGE(PG8_SB(0, 0), b2, voffB);
            PG8_BAR; PG8_WAIT_L(0); PG8_MMA(0, 1, At, B1); PG8_BAR;
            PG8_LDA(At, 0, 1); PG8_STAGE(PG8_SA(0, 0), a2, voffA);
            PG8_BAR; PG8_WAIT_L(0); PG8_MMA(1, 0, At, B0); PG8_BAR; PG8_SCHED;
            PG8_STAGE(PG8_SB(0, 1), b2 + hstep, voffB);
            PG8_WAIT_V(6); PG8_BAR; PG8_MMA(1, 1, At, B1); PG8_BAR;
            PG8_LDB(B0, 1, 0); PG8_SCHED; PG8_LDA(At, 1, 0); PG8_STAGE(PG8_SA(0, 1), a2 + hstep, voffA);
            PG8_WAIT_L(8); PG8_BAR; PG8_WAIT_L(0); PG8_MMA(0, 0, At, B0); PG8_BAR; PG8_SCHED;
            PG8_LDB(B1, 1, 1); PG8_STAGE(PG8_SB(1, 0), b3, voffB);
            PG8_BAR; PG8_WAIT_L(0); PG8_MMA(0, 1, At, B1); PG8_BAR;
            PG8_LDA(At, 1, 1); PG8_STAGE(PG8_SA(1, 0), a3, voffA);
            PG8_BAR; PG8_WAIT_L(0); PG8_MMA(1, 0, At, B0); PG8_BAR; PG8_SCHED;
            PG8_STAGE(PG8_SB(1, 1), b3 + hstep, voffB);
            PG8_WAIT_V(6); PG8_BAR; PG8_MMA(1, 1, At, B1); PG8_BAR;
            }
        }
        if constexpr (ALIGN_EPI) { if (wr == 0) PG8_BAR; }
        if constexpr (!Epi::AFTER_DRAIN) { E(acc, cur, wr, wc, fr, fq); S.done(cur); }
        if (!has_next) break;
#pragma unroll
        for (int a = 0; a < 2; ++a)
#pragma unroll
            for (int b = 0; b < 2; ++b)
#pragma unroll
                for (int m = 0; m < 4; ++m)
#pragma unroll
                    for (int n = 0; n < 2; ++n) acc[a][b][m][n] = (f32x4){0.f, 0.f, 0.f, 0.f};
        cur = nxt; cA = nA; cB = nB; ++ui;
        if constexpr (ALIGN_EPI) { if (wr == 1) PG8_BAR; }
    }
    PG8_WAIT_V(0);
    if constexpr (!ALIGN_EPI) { if (wr == 0) PG8_BAR; }
    PG8_BAR;
    if constexpr (Epi::AFTER_DRAIN) { E.fused(acc, cur, wr, wc, fr, fq, lds, wid, lane); S.done(cur); }
#undef PG8_SA
#undef PG8_SB
#undef PG8_STAGE
#undef PG8_LDA
#undef PG8_LDB
#undef PG8_MMA
#undef PG8_WAIT_V
#undef PG8_WAIT_L
#undef PG8_BAR
#undef PG8_SCHED
}
}

constexpr int NWAVES = 8;
constexpr int BATCH = 4, SEQ = 4096, DM = 2048, M = BATCH * SEQ;
constexpr int AH = 8, INW = 7184, PW = 7168, MIXW = 2048;
constexpr int PC_ZA = 3072, PC_UB = 4096, PC_VB = 5120, PC_ZB = 6144;
constexpr float EPS = 1e-6f;
constexpr size_t MiB = 1u << 20;
constexpr size_t WS_CTL = 0, CTL_ZERO_BYTES = 1 * MiB;
constexpr size_t WS_WT1 = 2 * MiB;
constexpr size_t WS_WT2 = 30 * MiB;
constexpr size_t WS_XN = 40 * MiB;
constexpr size_t WS_ORAW = 40 * MiB;
constexpr size_t WS_PROJ = 104 * MiB;
constexpr size_t WS_CONCAT = 328 * MiB;
constexpr size_t WS_AB = 392 * MiB, WS_GATES = 393 * MiB, WS_LNST = 394 * MiB, WS_ROWSS = 395 * MiB;
constexpr size_t WS_ACT = 400 * MiB;
constexpr int CW_BAR = 4096;
constexpr int RING_OFF = 0, RING_BYTES = 147456;
constexpr int LDSCTL_OFF = RING_BYTES, MISC_OFF = LDSCTL_OFF + 320;
constexpr int LDS_BYTES = 149504;

#define GAS __attribute__((address_space(1)))
#define LAS __attribute__((address_space(3)))
typedef unsigned short bf16;
typedef unsigned v4u __attribute__((ext_vector_type(4)));
typedef unsigned v2u __attribute__((ext_vector_type(2)));
typedef float f32x4 __attribute__((ext_vector_type(4)));
typedef GAS unsigned gu32;
#define RLX_AGENT __ATOMIC_RELAXED, __HIP_MEMORY_SCOPE_AGENT
#define LDS_WAIT() asm volatile("s_waitcnt lgkmcnt(0)" ::: "memory")
#define VM_WAIT() asm volatile("s_waitcnt vmcnt(0)" ::: "memory")
#define LBAR() do { asm volatile("s_waitcnt lgkmcnt(0)" ::: "memory"); __builtin_amdgcn_s_barrier(); asm volatile("" ::: "memory"); } while (0)
__device__ __forceinline__ unsigned f2bf(float f) { unsigned u = __builtin_bit_cast(unsigned, f); return (u + 0x7fffu + ((u >> 16) & 1u)) >> 16; }
__device__ __forceinline__ unsigned pk2(float lo, float hi) { return f2bf(lo) | (f2bf(hi) << 16); }
__device__ __forceinline__ float bf2f(unsigned b) { return __uint_as_float(b << 16); }
__device__ __forceinline__ float bflo(unsigned w) { return __uint_as_float(w << 16); }
__device__ __forceinline__ float bfhi(unsigned w) { return __uint_as_float(w & 0xffff0000u); }
__device__ __forceinline__ float silu(float x) { return x * __builtin_amdgcn_rcpf(1.f + __expf(-x)); }
__device__ __forceinline__ float sigmoidf_(float x) { return __builtin_amdgcn_rcpf(1.f + __expf(-x)); }
__device__ __forceinline__ float softplus_(float x) { return fmaxf(x, 0.f) + log1pf(__expf(-fabsf(x))); }
__device__ __forceinline__ float dpp_f(float old_, float src, int ctrl_unused) { return src; }
#define DPP_ADD(x, ctrl, rmask) ((x) + __builtin_bit_cast(float, __builtin_amdgcn_update_dpp(0, __builtin_bit_cast(int, (x)), (ctrl), (rmask), 0xf, false)))
__device__ __forceinline__ float wave_sum(float v) {
    float x = v;
    x = DPP_ADD(x, 0xB1, 0xf);
    x = DPP_ADD(x, 0x4E, 0xf);
    x = DPP_ADD(x, 0x124, 0xf);
    x = DPP_ADD(x, 0x128, 0xf);
    x = DPP_ADD(x, 0x142, 0xa);
    x = DPP_ADD(x, 0x143, 0xc);
    return __builtin_bit_cast(float, __builtin_amdgcn_readlane(__builtin_bit_cast(int, x), 63));
}
__device__ __forceinline__ float quad_sum(float v) { float x = v; x = DPP_ADD(x, 0xB1, 0xf); x = DPP_ADD(x, 0x4E, 0xf); return x; }

#define XB_TMO      128
#define XB_XCNT(j)  (256  + 64 * (j))
#define XB_XSUB(j)  (1280 + 64 * (j))
#define XB_XGEN(j)  (2304 + 64 * (j))
#define XB_TOP      3328
#define XB_TOPGEN   3392
#define XCD_BAR_WORDS 3456
#define XB_SPIN_CAP (1u << 18)

__device__ __forceinline__ unsigned xb_ld(unsigned* p)              { return __hip_atomic_load(p, __ATOMIC_RELAXED, __HIP_MEMORY_SCOPE_AGENT); }
__device__ __forceinline__ unsigned xb_add(unsigned* p, unsigned v) { return __hip_atomic_fetch_add(p, v, __ATOMIC_RELAXED, __HIP_MEMORY_SCOPE_AGENT); }
__device__ __forceinline__ unsigned xb_xcc_id() { return (unsigned)__builtin_amdgcn_s_getreg((3 << 11) | 20) & 0xFu; }
#define XB_SPIN(cond, bar) do { unsigned _sp = 0; while (cond) { __builtin_amdgcn_s_sleep(1); \
    if ((++_sp & 255u) == 0u) { if (xb_ld(&(bar)[XB_TMO])) break; if (_sp > XB_SPIN_CAP) { atomicAdd(&(bar)[XB_TMO], 1u); break; } } } } while (0)

struct XcdBarrier {
    unsigned* bar; unsigned x;
    volatile LAS unsigned* st;
};

__device__ __forceinline__ XcdBarrier xcd_barrier_post(unsigned* bar, volatile LAS unsigned* st) {
    XcdBarrier b; b.bar = bar; b.x = xb_xcc_id(); b.st = st;
    if (threadIdx.x == 0) (void)xb_add(&bar[XB_XCNT(b.x)], 1u);
    return b;
}
__device__ __forceinline__ void xcd_barrier_complete(unsigned* bar, unsigned x, unsigned& nloc, unsigned& nx) {
    const unsigned G = gridDim.x * gridDim.y * gridDim.z;
    unsigned sum, cnt, mine, sp = 0u;
    for (;;) {
        sum = 0u; cnt = 0u; mine = 0u;
#pragma unroll
        for (unsigned j = 0; j < 16; ++j) { const unsigned c = xb_ld(&bar[XB_XCNT(j)]); sum += c; cnt += (c > 0u) ? 1u : 0u; mine = (j == x) ? c : mine; }
        if (sum == G) break;
        __builtin_amdgcn_s_sleep(1);
        if ((++sp & 255u) == 0u) { if (xb_ld(&bar[XB_TMO])) break; if (sp > XB_SPIN_CAP) { atomicAdd(&bar[XB_TMO], 1u); break; } }
    }
    nloc = mine > 0u ? mine : 1u; nx = cnt > 0u ? cnt : 1u;
}

__device__ __forceinline__ void xcd_barrier(const XcdBarrier& b) {
    asm volatile("s_waitcnt vmcnt(0)" ::: "memory");
    __syncthreads();
    if (threadIdx.x == 0) {
        unsigned* bar = b.bar;
        __builtin_amdgcn_s_waitcnt(0);
        unsigned nloc = b.st[0], nx = b.st[1];
        if (nloc == 0u) { xcd_barrier_complete(bar, b.x, nloc, nx); b.st[0] = nloc; b.st[1] = nx; }
        const unsigned old = xb_add(&bar[XB_XSUB(b.x)], 1u);
        const unsigned gen = old / nloc;
        if (old + 1u == (gen + 1u) * nloc) {
            __builtin_amdgcn_fence(__ATOMIC_RELEASE, "agent");
            asm volatile("s_waitcnt vmcnt(0)" ::: "memory");
            const unsigned og = xb_add(&bar[XB_TOP], 1u);
            const unsigned tg = og / nx;
            if (og + 1u == (tg + 1u) * nx) xb_add(&bar[XB_TOPGEN], 1u);
            else XB_SPIN(xb_ld(&bar[XB_TOPGEN]) == tg, bar);
            __builtin_amdgcn_fence(__ATOMIC_ACQUIRE, "agent");
            xb_add(&bar[XB_XGEN(b.x)], 1u);
            asm volatile("s_waitcnt vmcnt(0)" ::: "memory");
        } else {
            XB_SPIN(xb_ld(&bar[XB_XGEN(b.x)]) == gen, bar);
            __builtin_amdgcn_fence(__ATOMIC_ACQUIRE, "agent");
            asm volatile("s_waitcnt vmcnt(0)" ::: "memory");
        }
    }
    __syncthreads();
}


#ifndef PROBE_SEL
#define PROBE_SEL 0
#endif
#ifndef PROBE_SCALE_US
#define PROBE_SCALE_US 400
#endif
constexpr size_t WS_TS = 394 * MiB + 600 * 1024;
#if PROBE_SEL
#define TS_SET(F, k, v) do { ((unsigned long long*)((F).ws + WS_TS))[(k)] = (v); } while (0)
#define TS_NOW() __builtin_amdgcn_s_memrealtime()
#else
#define TS_SET(F, k, v) do { } while (0)
#define TS_NOW() 0ull
#endif
struct Frame {
    unsigned char* lds;
    unsigned char* ws;
    int tid, lane, wave, vcu, G;
};
constexpr int ARG_OFF = MISC_OFF + 128;
__device__ __forceinline__ const float* argp(const Frame& F, int i) {
    const LAS unsigned* p = (const LAS unsigned*)((LAS unsigned char*)F.lds + ARG_OFF) + 2 * i;
    const unsigned lo = __builtin_amdgcn_readfirstlane(p[0]), hi = __builtin_amdgcn_readfirstlane(p[1]);
    return (const float*)(((unsigned long long)hi << 32) | lo);
}


__device__ __forceinline__ void relaunder(Frame& F) {
    int l; asm volatile("v_mbcnt_lo_u32_b32 %0, -1, 0\n\tv_mbcnt_hi_u32_b32 %0, -1, %0" : "=v"(l));
    F.lane = l; F.tid = F.wave * 64 + l; }
__device__ __forceinline__ void p0_transpose_item(const float* W, int srcN, int src_n0, int k0, bf16* WT, int K, int dst_row0, LAS float* scr, int lane) {
#pragma unroll 8
    for (int i = 0; i < 32; ++i) { const int kk = 2 * i + (lane >> 5); scr[kk * 33 + (lane & 31)] = W[(size_t)(k0 + kk) * srcN + src_n0 + (lane & 31)]; }
    LDS_WAIT(); asm volatile("" ::: "memory");
    const int c = lane & 7;
#pragma unroll
    for (int j = 0; j < 4; ++j) { const int n = (lane >> 3) + 8 * j; const LAS float* s = scr + (8 * c) * 33 + n;
        v4u o; o.x = pk2(s[0 * 33], s[1 * 33]); o.y = pk2(s[2 * 33], s[3 * 33]); o.z = pk2(s[4 * 33], s[5 * 33]); o.w = pk2(s[6 * 33], s[7 * 33]);
        *(GAS v4u*)(WT + (size_t)(dst_row0 + n) * K + k0 + 8 * c) = o; }
    LDS_WAIT(); asm volatile("" ::: "memory");
}
__device__ __forceinline__ void p0_prologue(Frame& F) {
    const float* const x = argp(F, 0);
    const float* const norm_w = argp(F, 1);
    const float* const w_in = argp(F, 2);
    const float* const w_out = argp(F, 11);
    bf16* const Wt1 = (bf16*)(F.ws + WS_WT1);
    bf16* const Wt2 = (bf16*)(F.ws + WS_WT2);
    bf16* const XN = (bf16*)(F.ws + WS_XN);
    float* const ab = (float*)(F.ws + WS_AB);
    LAS float* scr = (LAS float*)((LAS unsigned char*)F.lds + RING_OFF + F.wave * 16384);
    const int gw = F.vcu * NWAVES + F.wave, NGW = F.G * NWAVES;
    constexpr int I_1 = (DM / 64) * (PW / 32), I_2 = (MIXW / 64) * (DM / 32);
    for (int it = gw; it < I_1 + I_2; it += NGW) {
        if (it < I_1) { const int kb = it / (PW / 32), nb = it % (PW / 32), n0 = 32 * nb;
            p0_transpose_item(w_in, INW, n0 + (n0 >= 4096 ? 16 : 0), 64 * kb, Wt1, DM, n0, scr, F.lane); }
        else { const int r = it - I_1, kb = r / (DM / 32), nb = r % (DM / 32);
            p0_transpose_item(w_out, DM, 32 * nb, 64 * kb, Wt2, MIXW, 32 * nb, scr, F.lane); }
    }
    LBAR();
    LAS float* Wl = (LAS float*)((LAS unsigned char*)F.lds + RING_OFF);
    for (int idx = F.tid; idx < 16 * DM; idx += NWAVES * 64) { const int k = idx >> 4, c = idx & 15; Wl[c * DM + k] = w_in[(size_t)k * INW + 4096 + c] * norm_w[k]; }
    LBAR();
    for (int mp = gw; mp < M / 2; mp += NGW) {
        const int m0 = 2 * mp;
        const GAS f32x4* x0 = (const GAS f32x4*)(x + (size_t)m0 * DM) + F.lane;
        const GAS f32x4* x1 = (const GAS f32x4*)(x + (size_t)(m0 + 1) * DM) + F.lane;
        f32x4 v0[8], v1[8]; float s0 = 0.f, s1 = 0.f;
#pragma unroll
        for (int j = 0; j < 8; ++j) { v0[j] = x0[64 * j]; v1[j] = x1[64 * j]; }
#pragma unroll
        for (int j = 0; j < 8; ++j) { s0 += (v0[j].x * v0[j].x + v0[j].y * v0[j].y) + (v0[j].z * v0[j].z + v0[j].w * v0[j].w);
                                      s1 += (v1[j].x * v1[j].x + v1[j].y * v1[j].y) + (v1[j].z * v1[j].z + v1[j].w * v1[j].w); }
        const float r0 = rsqrtf(wave_sum(s0) * (1.f / DM) + EPS), r1 = rsqrtf(wave_sum(s1) * (1.f / DM) + EPS);
        float acc[32];
#pragma unroll
        for (int i = 0; i < 32; ++i) acc[i] = 0.f;
#pragma unroll
        for (int j = 0; j < 8; ++j)
#pragma unroll
            for (int c = 0; c < 16; ++c) { const f32x4 w = *(const LAS f32x4*)(Wl + c * DM + 256 * j + 4 * F.lane);
                acc[c] += (v0[j].x * w.x + v0[j].y * w.y) + (v0[j].z * w.z + v0[j].w * w.w);
                acc[16 + c] += (v1[j].x * w.x + v1[j].y * w.y) + (v1[j].z * w.z + v1[j].w * w.w);
                if ((c & 7) == 7) asm volatile("" ::: "memory"); }
#pragma unroll
        for (int i = 0; i < 16; ++i) { const bool up = F.lane & 32; const float send = up ? acc[i] : acc[i + 16], keep = up ? acc[i + 16] : acc[i]; acc[i] = keep + __shfl_xor(send, 32); }
#pragma unroll
        for (int i = 0; i < 8; ++i) { const bool up = F.lane & 16; const float send = up ? acc[i] : acc[i + 8], keep = up ? acc[i + 8] : acc[i]; acc[i] = keep + __shfl_xor(send, 16); }
#pragma unroll
        for (int i = 0; i < 4; ++i) { const bool up = F.lane & 8; const float send = up ? acc[i] : acc[i + 4], keep = up ? acc[i + 4] : acc[i]; acc[i] = keep + __shfl_xor(send, 8); }
#pragma unroll
        for (int i = 0; i < 2; ++i) { const bool up = F.lane & 4; const float send = up ? acc[i] : acc[i + 2], keep = up ? acc[i + 2] : acc[i]; acc[i] = keep + __shfl_xor(send, 4); }
        { const bool up = F.lane & 2; const float send = up ? acc[0] : acc[1], keep = up ? acc[1] : acc[0]; acc[0] = keep + __shfl_xor(send, 2); }
        acc[0] += __shfl_xor(acc[0], 1);
        if ((F.lane & 1) == 0) { const int i = F.lane >> 1; const int r = i >> 4, c = i & 15; ab[(size_t)(m0 + r) * 16 + c] = acc[0] * (r ? r1 : r0); }
        GAS unsigned long long* o0 = (GAS unsigned long long*)(XN + (size_t)m0 * DM) + F.lane;
        GAS unsigned long long* o1 = (GAS unsigned long long*)(XN + (size_t)(m0 + 1) * DM) + F.lane;
#pragma unroll
        for (int j = 0; j < 8; ++j) { const f32x4 nw = ((const GAS f32x4*)norm_w)[64 * j + F.lane];
            o0[64 * j] = (unsigned long long)pk2(v0[j].x * r0 * nw.x, v0[j].y * r0 * nw.y) | ((unsigned long long)pk2(v0[j].z * r0 * nw.z, v0[j].w * r0 * nw.w) << 32);
            o1[64 * j] = (unsigned long long)pk2(v1[j].x * r1 * nw.x, v1[j].y * r1 * nw.y) | ((unsigned long long)pk2(v1[j].z * r1 * nw.z, v1[j].w * r1 * nw.w) << 32); }
    }
}

__device__ __forceinline__ void naive_lnst(Frame& F) {
    bf16* const proj = (bf16*)(F.ws + WS_PROJ);
    float* const lnst = (float*)(F.ws + WS_LNST);
    const int gw = F.vcu * NWAVES + F.wave, NGW = F.G * NWAVES, lane = F.lane;
    for (int m = gw; m < M; m += NGW) {
        const v4u* p = (const v4u*)(proj + (size_t)m * PW + PC_VB + 16 * lane);
        const v4u a = p[0], b = p[1]; const unsigned w[8] = {a.x, a.y, a.z, a.w, b.x, b.y, b.z, b.w};
        float v[16]; float s = 0.f;
#pragma unroll
        for (int i = 0; i < 8; ++i) { v[2 * i] = bflo(w[i]); v[2 * i + 1] = bfhi(w[i]); s += v[2 * i] + v[2 * i + 1]; }
        const float mu = wave_sum(s) * (1.f / 1024.f); float q = 0.f;
#pragma unroll
        for (int i = 0; i < 16; ++i) { const float d = v[i] - mu; q += d * d; }
        const float rs = rsqrtf(wave_sum(q) * (1.f / 1024.f) + EPS);
        if (lane == 0) { lnst[2 * m] = mu; lnst[2 * m + 1] = rs; }
    }
}
__device__ __forceinline__ void naive_conv_gates(Frame& F) {
    const float* const conv_w = argp(F, 3);
    const float* const a_log = argp(F, 4);
    const float* const dt_bias = argp(F, 5);
    bf16* const proj = (bf16*)(F.ws + WS_PROJ);
    bf16* const act = (bf16*)(F.ws + WS_ACT);
    float* const ab = (float*)(F.ws + WS_AB);
    float* const gates = (float*)(F.ws + WS_GATES);
    const int gw = F.vcu * NWAVES + F.wave, NGW = F.G * NWAVES, lane = F.lane;
    for (int it = gw; it < M * 24; it += NGW) {
        const int m = it / 24, r = it % 24, t = m % SEQ, c = r * 128 + 2 * lane;
        float s0 = 0.f, s1 = 0.f;
#pragma unroll
        for (int j = 0; j < 4; ++j) { if (t - 3 + j >= 0) { const unsigned w = *(const unsigned*)(proj + (size_t)(m - 3 + j) * PW + c);
            s0 += conv_w[j * 3072 + c] * bflo(w); s1 += conv_w[j * 3072 + c + 1] * bfhi(w); } }
        s0 = silu(s0); s1 = silu(s1);
        if (r < 16) { const float sc = rsqrtf(wave_sum(s0 * s0 + s1 * s1) + EPS); s0 *= sc; s1 *= sc; }
        *(unsigned*)(act + (size_t)m * 3072 + c) = pk2(s0, s1);
    }
    for (int idx = (F.vcu * NWAVES * 64) + F.tid; idx < M * 8; idx += F.G * NWAVES * 64) {
        const int m = idx >> 3, h = idx & 7;
        gates[(size_t)m * 16 + h] = sigmoidf_(ab[(size_t)m * 16 + h]);
        gates[(size_t)m * 16 + 8 + h] = -__expf(a_log[h]) * softplus_(ab[(size_t)m * 16 + 8 + h] + dt_bias[h]);
    }
}
__device__ __forceinline__ void naive_scan(Frame& F, int b, int h) {
    bf16* const act = (bf16*)(F.ws + WS_ACT);
    float* const gates = (float*)(F.ws + WS_GATES);
    float* const oraw = (float*)(F.ws + WS_ORAW);
    float* kq = (float*)(F.lds + RING_OFF);
    const int tid = F.tid, e = (tid >> 1) & 127, half = tid & 1;
    float S[64];
#pragma unroll
    for (int d = 0; d < 64; ++d) S[d] = 0.f;
    const size_t m0 = (size_t)b * SEQ;
    const int ldcol = (tid < 128) ? (1024 + h * 128 + tid) : (h * 128 + ((tid - 128) & 127));
    float nkq = bf2f(act[m0 * 3072 + ldcol]), nv = bf2f(act[m0 * 3072 + 2048 + h * 128 + e]);
    for (int t = 0; t < SEQ; ++t) {
        const size_t m = m0 + t; const int buf = t & 1;
        if (tid < 256) kq[buf * 256 + tid] = nkq;
        const float v = nv;
        if (t + 1 < SEQ) { nkq = bf2f(act[(m + 1) * 3072 + ldcol]); nv = bf2f(act[(m + 1) * 3072 + 2048 + h * 128 + e]); }
        __syncthreads();
        if (tid < 256) {
            const float beta = gates[m * 16 + h], a = __expf(gates[m * 16 + 8 + h]);
            const float* kk = kq + buf * 256 + half * 64; const float* qq = kq + buf * 256 + 128 + half * 64;
            float k0 = 0.f, k1 = 0.f, k2 = 0.f, k3 = 0.f;
#pragma unroll
            for (int d = 0; d < 64; d += 4) { const float4 k4 = *(const float4*)(kk + d);
                k0 = fmaf(k4.x, S[d], k0); k1 = fmaf(k4.y, S[d + 1], k1); k2 = fmaf(k4.z, S[d + 2], k2); k3 = fmaf(k4.w, S[d + 3], k3); }
            float kS = (k0 + k1) + (k2 + k3); kS += __shfl_xor(kS, 1);
            const float vn = beta * (v - a * kS);
            float o0 = 0.f, o1 = 0.f, o2 = 0.f, o3 = 0.f;
#pragma unroll
            for (int d = 0; d < 64; d += 4) { const float4 k4 = *(const float4*)(kk + d); const float4 q4 = *(const float4*)(qq + d);
                S[d] = fmaf(a, S[d], k4.x * vn); S[d + 1] = fmaf(a, S[d + 1], k4.y * vn); S[d + 2] = fmaf(a, S[d + 2], k4.z * vn); S[d + 3] = fmaf(a, S[d + 3], k4.w * vn);
                o0 = fmaf(q4.x, S[d], o0); o1 = fmaf(q4.y, S[d + 1], o1); o2 = fmaf(q4.z, S[d + 2], o2); o3 = fmaf(q4.w, S[d + 3], o3); }
            float o = (o0 + o1) + (o2 + o3); o += __shfl_xor(o, 1);
            if (half == 0) oraw[m * 1024 + h * 128 + e] = o * 0.08838834764831845f;
        }
    }
}
__device__ __forceinline__ void naive_sgu(Frame& F, int first_block) {
    const float* const ln_w = argp(F, 7);
    const float* const ln_b = argp(F, 8);
    const float* const w_sp = argp(F, 9);
    const float* const b_sp = argp(F, 10);
    bf16* const proj = (bf16*)(F.ws + WS_PROJ);
    bf16* const concat = (bf16*)(F.ws + WS_CONCAT);
    float* const lnst = (float*)(F.ws + WS_LNST);
    const size_t nthr = (size_t)(F.G - first_block) * NWAVES * 64;
    for (size_t idx = (size_t)(blockIdx.x - first_block) * NWAVES * 64 + F.tid; idx < (size_t)M * 1024; idx += nthr) {
        const int ch = (int)(idx & 1023), m = (int)(idx >> 10), g = ch >> 7, t = m & 127, mb = m - t;
        const float* wrow = w_sp + ((size_t)g * 128 + t) * 128;
        const float lw = ln_w[ch], lb = ln_b[ch];
        float s = 0.f;
        for (int sp = 0; sp <= t; ++sp) { const float vb = bf2f(proj[(size_t)(mb + sp) * PW + PC_VB + ch]);
            const float vnv = (vb - lnst[2 * (mb + sp)]) * lnst[2 * (mb + sp) + 1] * lw + lb; s = fmaf(wrow[sp], vnv, s); }
        s += b_sp[g * 128 + t];
        const float u = bf2f(proj[(size_t)m * PW + PC_UB + ch]), z = bf2f(proj[(size_t)m * PW + PC_ZB + ch]);
        concat[(size_t)m * MIXW + 1024 + ch] = (bf16)f2bf(u * s * silu(z));
    }
}
__device__ __forceinline__ void naive_gateA(Frame& F) {
    const float* const head_w = argp(F, 6);
    bf16* const proj = (bf16*)(F.ws + WS_PROJ);
    bf16* const concat = (bf16*)(F.ws + WS_CONCAT);
    float* const oraw = (float*)(F.ws + WS_ORAW);
    const int gw = F.vcu * NWAVES + F.wave, NGW = F.G * NWAVES, lane = F.lane;
    for (int it = gw; it < M * 8; it += NGW) {
        const int m = it >> 3, h = it & 7;
        const float* p = oraw + (size_t)m * 1024 + h * 128 + 2 * lane;
        const float a = p[0], b = p[1];
        const float sc = rsqrtf(wave_sum(a * a + b * b) * (1.f / 128.f) + EPS);
        const unsigned z = *(const unsigned*)(proj + (size_t)m * PW + PC_ZA + h * 128 + 2 * lane);
        *(unsigned*)(concat + (size_t)m * MIXW + h * 128 + 2 * lane) = pk2(a * sc * head_w[2 * lane] * silu(bflo(z)), b * sc * head_w[2 * lane + 1] * silu(bfhi(z)));
    }
}
__device__ __forceinline__ void p5_final(Frame& F) {
    const float* const fin_w = argp(F, 12);
    float* const out = (float*)argp(F, 13);
    float* const rowss = (float*)(F.ws + WS_ROWSS);
    const int gw = F.vcu * NWAVES + F.wave, NGW = F.G * NWAVES, lane = F.lane;
    for (int m = gw; m < M; m += NGW) {
        const float part = (lane < 32) ? rowss[(size_t)m * 32 + lane] : 0.f;
        const float rs = rsqrtf(wave_sum(part) * (1.f / DM) + EPS);
        GAS f32x4* o = (GAS f32x4*)(out + (size_t)m * DM) + lane;
#pragma unroll
        for (int j = 0; j < 8; ++j) { const f32x4 w = ((const GAS f32x4*)fin_w)[64 * j + lane]; f32x4 v = o[64 * j]; v = v * rs * w;
#if PROBE_SEL
            if (j == 0 && lane < 16 && m < (int)((const unsigned long long*)(F.ws + WS_TS))[63]) v = v + 0.05f;
#endif
            o[64 * j] = v; }
    }
}


typedef short bf16x8 __attribute__((ext_vector_type(8)));
typedef float f32x16 __attribute__((ext_vector_type(16)));
typedef float f32x2 __attribute__((ext_vector_type(2)));
typedef __bf16 bf16x2v __attribute__((ext_vector_type(2)));
#define MFMA32(a, b, c) __builtin_amdgcn_mfma_f32_32x32x16_bf16((a), (b), (c), 0, 0, 0)
__device__ __forceinline__ unsigned pkc(float a, float b) { f32x2 v = {a, b}; bf16x2v r = __builtin_convertvector(v, bf16x2v); return __builtin_bit_cast(unsigned, r); }
__device__ __forceinline__ int crow(int reg, int h) { return (reg & 3) + 8 * (reg >> 2) + 4 * h; }
__device__ __forceinline__ bf16x8 pack_frag(const f32x16& x, int s, float sc) {
    v4u p; p.x = pkc(x[8 * s] * sc, x[8 * s + 1] * sc); p.y = pkc(x[8 * s + 2] * sc, x[8 * s + 3] * sc); p.z = pkc(x[8 * s + 4] * sc, x[8 * s + 5] * sc); p.w = pkc(x[8 * s + 6] * sc, x[8 * s + 7] * sc);
    return __builtin_bit_cast(bf16x8, p);
}
__device__ __forceinline__ f32x16 zero16() { f32x16 z; for (int i = 0; i < 16; ++i) z[i] = 0.f; return z; }

constexpr size_t WS_UBUF = 40 * MiB;
constexpr size_t WS_WFRAG = 400 * MiB;
constexpr size_t WS_QFRAG = 432 * MiB;
constexpr size_t WS_KFRAG = 464 * MiB;
constexpr size_t WS_AFRAG = 496 * MiB;
constexpr size_t WS_GAMMA = 394 * MiB + 512 * 1024;

constexpr int AL_KL = 0, AL_QL = 17408, AL_KT = 34816, AL_VT = 53248, AL_LF = 71680, AL_TF = 89088, AL_TB = 106496, AL_TG = 115712, AL_GC = 124928, AL_BETA = 125184, AL_DEC = 125440, AL_EG = 125696, AL_PF = 0;
constexpr int KLS = 136, KTS = 72, LFS = 68;

__device__ __forceinline__ void a_local_unit(Frame& F, int b, int h, int n) {
    const float* const conv_w = argp(F, 3);
    const float* const a_log = argp(F, 4);
    const float* const dt_bias = argp(F, 5);
    bf16* const proj = (bf16*)(F.ws + WS_PROJ);
    float* const ab = (float*)(F.ws + WS_AB);
    LAS unsigned char* L = (LAS unsigned char*)F.lds;
    LAS bf16* KL = (LAS bf16*)(L + AL_KL); LAS bf16* QL = (LAS bf16*)(L + AL_QL); LAS bf16* KT = (LAS bf16*)(L + AL_KT); LAS bf16* VT = (LAS bf16*)(L + AL_VT);
    LAS float* LF = (LAS float*)(L + AL_LF); LAS float* TF = (LAS float*)(L + AL_TF); LAS float* PF = (LAS float*)(L + AL_PF);
    LAS bf16* TB = (LAS bf16*)(L + AL_TB); LAS bf16* TG = (LAS bf16*)(L + AL_TG);
    LAS float* GC = (LAS float*)(L + AL_GC); LAS float* BETA = (LAS float*)(L + AL_BETA); LAS float* DEC = (LAS float*)(L + AL_DEC); LAS float* EG = (LAS float*)(L + AL_EG);
    const int tid = F.tid, lane = F.lane, w = F.wave, r = lane & 31, hh = lane >> 5;
    const int t0 = n * 64; const size_t m0 = (size_t)b * SEQ + t0; const int unit = n * 32 + b * 8 + h;
    const float qscale = 0.08838834764831845f;
    for (int i = tid; i < 64 * LFS; i += NWAVES * 64) TF[i] = 0.f;
    if (w == 0) {
        const size_t m = m0 + lane;
        const float beta = sigmoidf_(ab[m * 16 + h]);
        const float g = -__expf(a_log[h]) * softplus_(ab[m * 16 + 8 + h] + dt_bias[h]);
        float gc = g;
#pragma unroll
        for (int o = 1; o < 64; o <<= 1) { const float t = __shfl_up(gc, o); if (lane >= o) gc += t; }
        const float glast = __shfl(gc, 63);
        GC[lane] = gc; BETA[lane] = beta; DEC[lane] = __expf(glast - gc); EG[lane] = __expf(gc);
        if (lane == 63) ((float*)(F.ws + WS_GAMMA))[unit] = __expf(glast);
    }
    {
        unsigned raw[3][11];
#pragma unroll
        for (int p = 0; p < 3; ++p)
#pragma unroll
            for (int i = 0; i < 11; ++i) { const int tt = t0 + 8 * w - 3 + i;
                raw[p][i] = (tt >= 0) ? *(const unsigned*)(proj + (m0 + 8 * w - 3 + i) * PW + p * 1024 + h * 128 + 2 * lane) : 0u; }
        float val[3][8][2];
#pragma unroll
        for (int p = 0; p < 3; ++p) {
            float cw0[4], cw1[4];
#pragma unroll
            for (int j = 0; j < 4; ++j) { const f32x2 c2 = *(const f32x2*)(conv_w + j * 3072 + p * 1024 + h * 128 + 2 * lane); cw0[j] = c2.x; cw1[j] = c2.y; }
#pragma unroll
            for (int i = 0; i < 8; ++i) { float s0 = 0.f, s1 = 0.f;
#pragma unroll
                for (int j = 0; j < 4; ++j) { s0 += cw0[j] * bflo(raw[p][i + j]); s1 += cw1[j] * bfhi(raw[p][i + j]); }
                s0 = silu(s0); s1 = silu(s1);
                if (p < 2) { const float sc = rsqrtf(wave_sum(s0 * s0 + s1 * s1) + EPS); s0 *= sc; s1 *= sc; }
                val[p][i][0] = s0; val[p][i][1] = s1; }
        }
#pragma unroll
        for (int i = 0; i < 8; ++i) {
            *(LAS unsigned*)(QL + (8 * w + i) * KLS + 2 * lane) = pkc(val[0][i][0], val[0][i][1]);
            *(LAS unsigned*)(KL + (8 * w + i) * KLS + 2 * lane) = pkc(val[1][i][0], val[1][i][1]);
        }
#pragma unroll
        for (int e = 0; e < 2; ++e) {
            v4u kk, vv;
            kk.x = pkc(val[1][0][e], val[1][1][e]); kk.y = pkc(val[1][2][e], val[1][3][e]); kk.z = pkc(val[1][4][e], val[1][5][e]); kk.w = pkc(val[1][6][e], val[1][7][e]);
            vv.x = pkc(val[2][0][e], val[2][1][e]); vv.y = pkc(val[2][2][e], val[2][3][e]); vv.z = pkc(val[2][4][e], val[2][5][e]); vv.w = pkc(val[2][6][e], val[2][7][e]);
            *(LAS v4u*)(KT + (2 * lane + e) * KTS + 8 * w) = kk;
            *(LAS v4u*)(VT + (2 * lane + e) * KTS + 8 * w) = vv;
        }
    }
    LBAR();
#pragma unroll
    for (int i = 0; i < 2; ++i) {
        const int f = w + 8 * i;
        { const int ct = f >> 3, dt = (f & 7) >> 1, s = f & 1; const int c = 32 * ct + r, d0 = 32 * dt + 16 * s + 4 * hh;
          const v2u lo = *(const LAS v2u*)(QL + c * KLS + d0), hi = *(const LAS v2u*)(QL + c * KLS + d0 + 8);
          const float sc = qscale * EG[c];
          v4u o; o.x = pkc(bflo(lo.x) * sc, bfhi(lo.x) * sc); o.y = pkc(bflo(lo.y) * sc, bfhi(lo.y) * sc); o.z = pkc(bflo(hi.x) * sc, bfhi(hi.x) * sc); o.w = pkc(bflo(hi.y) * sc, bfhi(hi.y) * sc);
          *(GAS v4u*)(F.ws + WS_QFRAG + (((size_t)unit * 16 + f) * 64 + lane) * 16) = o; }
        { const int dt = f >> 2, ct = (f & 3) >> 1, s = f & 1; const int d = 32 * dt + r, c0 = 32 * ct + 16 * s + 4 * hh;
          const v2u lo = *(const LAS v2u*)(KT + d * KTS + c0), hi = *(const LAS v2u*)(KT + d * KTS + c0 + 8);
          const f32x4 d0 = *(const LAS f32x4*)(DEC + c0), d1 = *(const LAS f32x4*)(DEC + c0 + 8);
          v4u o; o.x = pkc(bflo(lo.x) * d0.x, bfhi(lo.x) * d0.y); o.y = pkc(bflo(lo.y) * d0.z, bfhi(lo.y) * d0.w); o.z = pkc(bflo(hi.x) * d1.x, bfhi(hi.x) * d1.y); o.w = pkc(bflo(hi.y) * d1.z, bfhi(hi.y) * d1.w);
          *(GAS v4u*)(F.ws + WS_KFRAG + (((size_t)unit * 16 + f) * 64 + lane) * 16) = o; }
    }
    if (w < 6) {
        const int ta = (w == 0) ? 0 : (w == 1) ? 1 : (w == 2) ? 1 : (w == 3) ? 0 : (w == 4) ? 0 : 1;
        const int tb = (w == 0) ? 0 : (w == 1) ? 0 : (w == 2) ? 1 : (w == 3) ? 0 : (w == 4) ? 1 : 1;
        const LAS bf16* Bsrc = (w < 3) ? KL : QL;
        f32x16 acc = zero16();
#pragma unroll
        for (int s = 0; s < 8; ++s) {
            const bf16x8 a = *(const LAS bf16x8*)(KL + (32 * ta + r) * KLS + 16 * s + 8 * hh);
            const bf16x8 bb = *(const LAS bf16x8*)(Bsrc + (32 * tb + r) * KLS + 16 * s + 8 * hh);
            acc = MFMA32(a, bb, acc);
        }
        if (w < 3) {
            const int cp = 32 * tb + r; const float gcp = GC[cp];
#pragma unroll
            for (int i = 0; i < 16; ++i) { const int c = 32 * ta + crow(i, hh);
                LF[c * LFS + cp] = (c > cp) ? BETA[c] * acc[i] * __expf(GC[c] - gcp) : 0.f; }
        } else {
            const int c = 32 * tb + r; const float gcc = GC[c];
            f32x16 av;
#pragma unroll
            for (int i = 0; i < 16; ++i) { const int cp = 32 * ta + crow(i, hh); av[i] = (c >= cp) ? qscale * acc[i] * __expf(gcc - GC[cp]) : 0.f; }
            const int idx = w - 3;
#pragma unroll
            for (int s = 0; s < 2; ++s) { const bf16x8 fr = pack_frag(av, s, 1.f);
                *(GAS bf16x8*)(F.ws + WS_AFRAG + (((size_t)unit * 6 + idx * 2 + s) * 64 + lane) * 16) = fr; }
        }
    }
    LBAR();
    if (tid < 64) {
        const int blk = tid >> 4, col = tid & 15; float x[16];
#pragma unroll
        for (int i = 0; i < 16; ++i) { float s = (i == col) ? 1.f : 0.f;
#pragma unroll
            for (int j = 0; j < i; ++j) s -= LF[(16 * blk + i) * LFS + 16 * blk + j] * x[j];
            x[i] = s; if ((i & 3) == 3) asm volatile("" ::: "memory"); }
#pragma unroll
        for (int i = 0; i < 16; ++i) TF[(16 * blk + i) * LFS + 16 * blk + col] = x[i];
    }
    LBAR();
    {
        const int p = tid >> 8, i = (tid >> 4) & 15, l = tid & 15; float s = 0.f;
#pragma unroll
        for (int k = 0; k < 16; ++k) s += LF[(32 * p + 16 + i) * LFS + 32 * p + k] * TF[(32 * p + k) * LFS + 32 * p + l];
        PF[(32 * p + 16 + i) * LFS + 32 * p + l] = s;
        LBAR();
        float t = 0.f;
#pragma unroll
        for (int j = 0; j < 16; ++j) t += TF[(32 * p + 16 + i) * LFS + 32 * p + 16 + j] * PF[(32 * p + 16 + j) * LFS + 32 * p + l];
        TF[(32 * p + 16 + i) * LFS + 32 * p + l] = -t;
    }
    LBAR();
    {
#pragma unroll
        for (int e = 0; e < 2; ++e) { const int o = tid + 512 * e, i = o >> 5, l = o & 31; float s = 0.f;
#pragma unroll 8
            for (int k = 0; k < 32; ++k) s += LF[(32 + i) * LFS + k] * TF[k * LFS + l];
            PF[(32 + i) * LFS + l] = s; }
        LBAR();
        float tv[2];
#pragma unroll
        for (int e = 0; e < 2; ++e) { const int o = tid + 512 * e, i = o >> 5, l = o & 31; float t = 0.f;
#pragma unroll 8
            for (int j = 0; j < 32; ++j) t += TF[(32 + i) * LFS + 32 + j] * PF[(32 + j) * LFS + l];
            tv[e] = -t; }
#pragma unroll
        for (int e = 0; e < 2; ++e) { const int o = tid + 512 * e, i = o >> 5, l = o & 31; TF[(32 + i) * LFS + l] = tv[e]; }
    }
    LBAR();
    {
        const int c = tid >> 3, c0 = (tid & 7) * 8; float tb[8], tg[8];
#pragma unroll
        for (int j = 0; j < 8; ++j) { const float t = TF[c * LFS + c0 + j] * BETA[c0 + j]; tb[j] = t; tg[j] = t * EG[c0 + j]; }
        v4u a, g; a.x = pkc(tb[0], tb[1]); a.y = pkc(tb[2], tb[3]); a.z = pkc(tb[4], tb[5]); a.w = pkc(tb[6], tb[7]);
        g.x = pkc(tg[0], tg[1]); g.y = pkc(tg[2], tg[3]); g.z = pkc(tg[4], tg[5]); g.w = pkc(tg[6], tg[7]);
        *(LAS v4u*)(TB + c * KTS + c0) = a; *(LAS v4u*)(TG + c * KTS + c0) = g;
    }
    LBAR();
    {
        const int ct = w & 1, et = w >> 1; f32x16 acc = zero16();
#pragma unroll
        for (int s = 0; s < 4; ++s) {
            const bf16x8 a = *(const LAS bf16x8*)(TB + (32 * ct + r) * KTS + 16 * s + 8 * hh);
            const bf16x8 bb = *(const LAS bf16x8*)(VT + (32 * et + r) * KTS + 16 * s + 8 * hh);
            acc = MFMA32(a, bb, acc);
        }
        GAS v4u* up = (GAS v4u*)(F.ws + WS_UBUF + ((((size_t)unit * 4 + et) * 2 + ct) * 64 + lane) * 32);
        up[0] = (v4u){pkc(acc[0], acc[1]), pkc(acc[2], acc[3]), pkc(acc[4], acc[5]), pkc(acc[6], acc[7])};
        up[1] = (v4u){pkc(acc[8], acc[9]), pkc(acc[10], acc[11]), pkc(acc[12], acc[13]), pkc(acc[14], acc[15])};
    }
    {
        const int dt = w & 3, ct = w >> 2; f32x16 acc = zero16();
#pragma unroll
        for (int s = 0; s < 4; ++s) {
            const bf16x8 a = *(const LAS bf16x8*)(KT + (32 * dt + r) * KTS + 16 * s + 8 * hh);
            const bf16x8 bb = *(const LAS bf16x8*)(TG + (32 * ct + r) * KTS + 16 * s + 8 * hh);
            acc = MFMA32(a, bb, acc);
        }
#pragma unroll
        for (int s = 0; s < 2; ++s) { const bf16x8 fr = pack_frag(acc, s, -1.f);
            *(GAS bf16x8*)(F.ws + WS_WFRAG + (((size_t)unit * 16 + ct * 8 + dt * 2 + s) * 64 + lane) * 16) = fr; }
    }
    LBAR();
}

constexpr int SC_OPB = 55296;
constexpr int SC_OP0 = 0, SC_OBUF = 2 * SC_OPB;
constexpr int OBS = 136;
constexpr int SC_HW = SC_OBUF + 2 * 64 * OBS * 2;
__device__ __forceinline__ void scan_finish_chunk(Frame& F, LAS unsigned char* L, int b, int h, int nprev, int oc, int oq, const v4u (&zv)[4], const float* head_w) {
    bf16* const concat = (bf16*)(F.ws + WS_CONCAT);
    const LAS bf16* ob = (const LAS bf16*)(L + SC_OBUF + (nprev & 1) * (64 * OBS * 2)) + oc * OBS + 32 * oq;
    const size_t m = (size_t)b * SEQ + (size_t)nprev * 64 + oc;
    v4u ov[4];
#pragma unroll
    for (int i = 0; i < 4; ++i) ov[i] = *(const LAS v4u*)(ob + 8 * i);
    float ss = 0.f;
#pragma unroll
    for (int i = 0; i < 4; ++i) { const unsigned ww[4] = {ov[i].x, ov[i].y, ov[i].z, ov[i].w};
#pragma unroll
        for (int j = 0; j < 4; ++j) { const float a = bflo(ww[j]), c = bfhi(ww[j]); ss += a * a + c * c; } }
    ss = quad_sum(ss);
    const float rs = rsqrtf(ss * (1.f / 128.f) + EPS);
#pragma unroll
    for (int i = 0; i < 4; ++i) { const unsigned ww[4] = {ov[i].x, ov[i].y, ov[i].z, ov[i].w}; const unsigned zz[4] = {zv[i].x, zv[i].y, zv[i].z, zv[i].w}; unsigned oo[4];
        const f32x4 h0 = *(const LAS f32x4*)(L + SC_HW + (32 * oq + 8 * i) * 4), h1 = *(const LAS f32x4*)(L + SC_HW + (32 * oq + 8 * i + 4) * 4);
        const float hw[8] = {h0.x, h0.y, h0.z, h0.w, h1.x, h1.y, h1.z, h1.w};
#pragma unroll
        for (int j = 0; j < 4; ++j) oo[j] = pkc(bflo(ww[j]) * rs * hw[2 * j] * silu(bflo(zz[j])), bfhi(ww[j]) * rs * hw[2 * j + 1] * silu(bfhi(zz[j])));
        *(GAS v4u*)(concat + m * MIXW + h * 128 + 32 * oq + 8 * i) = (v4u){oo[0], oo[1], oo[2], oo[3]}; }
}
__device__ __forceinline__ void scan_head(Frame& F, int b, int h) {
    LAS unsigned char* L = (LAS unsigned char*)F.lds;
    const int w = F.wave;
    const int unit0 = b * 8 + h;
    if (w < 4) {
        int lane; asm volatile("v_mbcnt_lo_u32_b32 %0, -1, 0\n\tv_mbcnt_hi_u32_b32 %0, -1, %0" : "=v"(lane));
        const int r = lane & 31, hh = lane >> 5;
        unsigned long long pacc = 0ull;
        f32x16 S[4];
#pragma unroll
        for (int dt = 0; dt < 4; ++dt) S[dt] = zero16();
        v4u Un[2][2]; float gamma_n;
#define SC_ULOAD(u) do { _Pragma("unroll") for (int ct_ = 0; ct_ < 2; ++ct_) { const GAS v4u* up_ = (const GAS v4u*)(F.ws + WS_UBUF + ((((size_t)(u) * 4 + w) * 2 + ct_) * 64 + lane) * 32); \
            Un[ct_][0] = up_[0]; Un[ct_][1] = up_[1]; } gamma_n = ((const float*)(F.ws + WS_GAMMA))[(u)]; } while (0)
#define SC_LD8(dst, base) do { _Pragma("unroll") for (int i_ = 0; i_ < 8; ++i_) dst[i_] = *(const LAS bf16x8*)(ops + (base) + i_ * 1024 + lane * 16); } while (0)
#define SC_SB __builtin_amdgcn_sched_barrier(0)
#define SC_SFR(i) pack_frag(S[(i) >> 1], (i) & 1, 1.f)
        SC_ULOAD(unit0);
        LBAR();
        for (int n = 0; n < 64; ++n) {
            const LAS unsigned char* ops = L + SC_OP0 + (n & 1) * SC_OPB;
            LAS bf16* ob = (LAS bf16*)(L + SC_OBUF + (n & 1) * (64 * OBS * 2));
            bf16x8 fa[8], fb[8];
            SC_LD8(fa, 0); SC_LD8(fb, 8192);
            unsigned u0[8], u1[8];
            u0[0] = Un[0][0].x; u0[1] = Un[0][0].y; u0[2] = Un[0][0].z; u0[3] = Un[0][0].w; u0[4] = Un[0][1].x; u0[5] = Un[0][1].y; u0[6] = Un[0][1].z; u0[7] = Un[0][1].w;
            u1[0] = Un[1][0].x; u1[1] = Un[1][0].y; u1[2] = Un[1][0].z; u1[3] = Un[1][0].w; u1[4] = Un[1][1].x; u1[5] = Un[1][1].y; u1[6] = Un[1][1].z; u1[7] = Un[1][1].w;
            const float gamma = gamma_n;
            SC_SB;
            if (n + 1 < 64) SC_ULOAD(unit0 + 32 * (n + 1));
            SC_SB;
            bf16x8 Vb[2][2];
            {   f32x16 R;
#pragma unroll
                for (int i = 0; i < 8; ++i) { R[2 * i] = bflo(u0[i]); R[2 * i + 1] = bfhi(u0[i]); }
#pragma unroll
                for (int i = 0; i < 8; ++i) R = MFMA32(fa[i], SC_SFR(i), R);
                Vb[0][0] = pack_frag(R, 0, 1.f); Vb[0][1] = pack_frag(R, 1, 1.f); }
            SC_SB; SC_LD8(fa, 16384); SC_SB;
            {   f32x16 R;
#pragma unroll
                for (int i = 0; i < 8; ++i) { R[2 * i] = bflo(u1[i]); R[2 * i + 1] = bfhi(u1[i]); }
#pragma unroll
                for (int i = 0; i < 8; ++i) R = MFMA32(fb[i], SC_SFR(i), R);
                Vb[1][0] = pack_frag(R, 0, 1.f); Vb[1][1] = pack_frag(R, 1, 1.f); }
            SC_SB; SC_LD8(fb, 16384 + 8192); SC_SB;
            f32x16 O0 = zero16(), O1 = zero16();
#pragma unroll
            for (int i = 0; i < 8; ++i) O0 = MFMA32(fa[i], SC_SFR(i), O0);
            SC_SB;
#pragma unroll
            for (int i = 0; i < 6; ++i) fa[i] = *(const LAS bf16x8*)(ops + 49152 + i * 1024 + lane * 16);
            SC_SB;
#pragma unroll
            for (int i = 0; i < 8; ++i) O1 = MFMA32(fb[i], SC_SFR(i), O1);
            SC_SB; SC_LD8(fb, 32768); SC_SB;
            O0 = MFMA32(fa[0], Vb[0][0], O0); O0 = MFMA32(fa[1], Vb[0][1], O0);
            O1 = MFMA32(fa[2], Vb[0][0], O1); O1 = MFMA32(fa[3], Vb[0][1], O1); O1 = MFMA32(fa[4], Vb[1][0], O1); O1 = MFMA32(fa[5], Vb[1][1], O1);
            SC_SB; SC_LD8(fa, 32768 + 8192); SC_SB;
            S[0] = S[0] * gamma; S[1] = S[1] * gamma;
#pragma unroll
            for (int i = 0; i < 8; ++i) S[i >> 2] = MFMA32(fb[i], Vb[(i >> 1) & 1][i & 1], S[i >> 2]);
#pragma unroll
            for (int i = 0; i < 16; ++i) { ob[(crow(i, hh)) * OBS + 32 * w + r] = (bf16)(pkc(O0[i], 0.f) & 0xffffu); ob[(32 + crow(i, hh)) * OBS + 32 * w + r] = (bf16)(pkc(O1[i], 0.f) & 0xffffu); }
            SC_SB;
            S[2] = S[2] * gamma; S[3] = S[3] * gamma;
#pragma unroll
            for (int i = 0; i < 8; ++i) S[2 + (i >> 2)] = MFMA32(fa[i], Vb[(i >> 1) & 1][i & 1], S[2 + (i >> 2)]);
            { const unsigned long long t0_ = TS_NOW(); LBAR(); if (PROBE_SEL == 2) pacc += TS_NOW() - t0_; }
        }
        LBAR();
        if (PROBE_SEL == 2 && blockIdx.x == 0 && w == 0 && lane == 0) { TS_SET(F, 0, 0ull); TS_SET(F, 1, pacc); }
#undef SC_SFR
#undef SC_ULOAD
#undef SC_LD8
#undef SC_SB
    } else {
        bf16* const proj = (bf16*)(F.ws + WS_PROJ); const float* const head_w = argp(F, 6);
        int lane; asm volatile("v_mbcnt_lo_u32_b32 %0, -1, 0\n\tv_mbcnt_hi_u32_b32 %0, -1, %0" : "=v"(lane));
        const int ltid = (w - 4) * 64 + lane;
        const int oc = (ltid >> 2) & 63, oq = ltid & 3;
        v4u pa[14], zz[4], zn[4]; unsigned long long lacc = 0ull;
#define SC_ISSUE(pre, u) do { \
        const GAS v4u* gw_ = (const GAS v4u*)(F.ws + WS_WFRAG + (size_t)(u) * 16384); const GAS v4u* gq_ = (const GAS v4u*)(F.ws + WS_QFRAG + (size_t)(u) * 16384); \
        const GAS v4u* gk_ = (const GAS v4u*)(F.ws + WS_KFRAG + (size_t)(u) * 16384); const GAS v4u* ga_ = (const GAS v4u*)(F.ws + WS_AFRAG + (size_t)(u) * 6144); \
        _Pragma("unroll") for (int i_ = 0; i_ < 4; ++i_) { pre[i_] = gw_[ltid + 256 * i_]; pre[4 + i_] = gq_[ltid + 256 * i_]; pre[8 + i_] = gk_[ltid + 256 * i_]; } \
        pre[12] = ga_[ltid]; pre[13] = ga_[256 + (ltid & 127)]; } while (0)
#define SC_COMMIT(pre, bufi) do { LAS v4u* d_ = (LAS v4u*)(L + SC_OP0 + (bufi) * SC_OPB); \
        _Pragma("unroll") for (int i_ = 0; i_ < 13; ++i_) d_[ltid + 256 * i_] = pre[i_]; \
        d_[(ltid & 127) + 256 * 13] = pre[13]; } while (0)
#define SC_ZLOAD(z, nn) do { const GAS v4u* zp_ = (const GAS v4u*)(proj + ((size_t)b * SEQ + (size_t)(nn) * 64 + oc) * PW + PC_ZA + h * 128 + 32 * oq); \
        _Pragma("unroll") for (int i_ = 0; i_ < 4; ++i_) z[i_] = zp_[i_]; } while (0)
        if (ltid < 128) *(LAS float*)(L + SC_HW + 4 * ltid) = head_w[ltid];
        SC_ISSUE(pa, unit0); SC_COMMIT(pa, 0); SC_ISSUE(pa, unit0 + 32);
        LBAR();
#define SC_LSTEP(nn, zuse, zload) do { \
            { const unsigned long long t0_ = TS_NOW(); if ((nn) + 1 < 64) SC_COMMIT(pa, ((nn) + 1) & 1); asm volatile("s_waitcnt lgkmcnt(0)" ::: "memory"); if (PROBE_SEL == 4) lacc += TS_NOW() - t0_; } \
            asm volatile("" :: "v"(zuse[0]), "v"(zuse[1]), "v"(zuse[2]), "v"(zuse[3]));        \
            if ((nn) + 2 < 64) SC_ISSUE(pa, unit0 + 32 * ((nn) + 2)); \
            SC_ZLOAD(zload, (nn)); \
            if ((nn) >= 1) scan_finish_chunk(F, L, b, h, (nn) - 1, oc, oq, zuse, head_w); \
            { const unsigned long long t0_ = TS_NOW(); LBAR(); if (PROBE_SEL == 3) lacc += TS_NOW() - t0_; } } while (0)
        for (int n = 0; n < 64; n += 2) { SC_LSTEP(n, zn, zz); SC_LSTEP(n + 1, zz, zn); }
        scan_finish_chunk(F, L, b, h, 63, oc, oq, zn, head_w);
        LBAR();
#undef SC_LSTEP
        if ((PROBE_SEL == 3 || PROBE_SEL == 4) && blockIdx.x == 0 && ltid == 0) { TS_SET(F, 0, 0ull); TS_SET(F, 1, lacc); }
#undef SC_ISSUE
#undef SC_COMMIT
#undef SC_ZLOAD
    }
}

constexpr int BU_MU = 0, BU_RS = 512, BU_VNT = 1024, VNS = 136, BU_OUT = 1024 + 2 * 128 * VNS * 2, OUS = 132;
__device__ __forceinline__ void b_unit(Frame& F, int b, int nchunk, int ghalf) {
    const float* const ln_w = argp(F, 7); const float* const ln_b = argp(F, 8); const float* const w_sp = argp(F, 9); const float* const b_sp = argp(F, 10);
    bf16* const proj = (bf16*)(F.ws + WS_PROJ); bf16* const concat = (bf16*)(F.ws + WS_CONCAT);
    LAS unsigned char* L = (LAS unsigned char*)F.lds;
    LAS float* MU = (LAS float*)(L + BU_MU); LAS float* RS = (LAS float*)(L + BU_RS); LAS float* OUT = (LAS float*)(L + BU_OUT);
    const int tid = F.tid, lane = F.lane, w = F.wave, r = lane & 31, hh = lane >> 5;
    const size_t m0 = (size_t)b * SEQ + (size_t)nchunk * 128;
#pragma unroll 4
    for (int i = 0; i < 16; ++i) {
        const int s = 16 * w + i;
        const GAS v4u* p = (const GAS v4u*)(proj + (m0 + s) * PW + PC_VB + 16 * lane);
        const v4u a = p[0], c = p[1]; const unsigned ww[8] = {a.x, a.y, a.z, a.w, c.x, c.y, c.z, c.w};
        float v[16]; float sm = 0.f;
#pragma unroll
        for (int j = 0; j < 8; ++j) { v[2 * j] = bflo(ww[j]); v[2 * j + 1] = bfhi(ww[j]); sm += v[2 * j] + v[2 * j + 1]; }
        const float mu = wave_sum(sm) * (1.f / 1024.f); float q = 0.f;
#pragma unroll
        for (int j = 0; j < 16; ++j) { const float d = v[j] - mu; q += d * d; }
        const float rs = rsqrtf(wave_sum(q) * (1.f / 1024.f) + EPS);
        if (lane == 0) { MU[s] = mu; RS[s] = rs; }
    }
    LBAR();
    for (int gi = 0; gi < 4; ++gi) {
        const int g = ghalf * 4 + gi;
        LAS bf16* VNT = (LAS bf16*)(L + BU_VNT + (gi & 1) * (128 * VNS * 2));
        {
            const int s = tid & 127; const float mu = MU[s], rs = RS[s];
#pragma unroll
            for (int i = 0; i < 4; ++i) { const int cc = (tid >> 7) + 4 * i;
                const v4u raw = *(const GAS v4u*)(proj + (m0 + s) * PW + PC_VB + g * 128 + 8 * cc);
                const f32x4 w0 = *(const GAS f32x4*)(ln_w + g * 128 + 8 * cc), w1 = *(const GAS f32x4*)(ln_w + g * 128 + 8 * cc + 4);
                const f32x4 b0 = *(const GAS f32x4*)(ln_b + g * 128 + 8 * cc), b1 = *(const GAS f32x4*)(ln_b + g * 128 + 8 * cc + 4);
                const unsigned ww[4] = {raw.x, raw.y, raw.z, raw.w}; const float lw[8] = {w0.x, w0.y, w0.z, w0.w, w1.x, w1.y, w1.z, w1.w}; const float lb[8] = {b0.x, b0.y, b0.z, b0.w, b1.x, b1.y, b1.z, b1.w};
#pragma unroll
                for (int j = 0; j < 4; ++j) {
                    const float v0 = (bflo(ww[j]) - mu) * rs * lw[2 * j] + lb[2 * j], v1 = (bfhi(ww[j]) - mu) * rs * lw[2 * j + 1] + lb[2 * j + 1];
                    const unsigned pk = pkc(v0, v1);
                    VNT[(8 * cc + 2 * j) * VNS + s] = (bf16)(pk & 0xffffu); VNT[(8 * cc + 2 * j + 1) * VNS + s] = (bf16)(pk >> 16); }
            }
        }
        LBAR();
        {
            const int tt = w >> 1, cc0 = 2 * (w & 1);
            f32x16 acc0 = zero16(), acc1 = zero16();
            const int t = 32 * tt + r;
            const float* wrow = w_sp + ((size_t)g * 128 + t) * 128;
            for (int ks = 0; ks < 2 * tt + 2; ++ks) {
                const int s0 = 16 * ks + 8 * hh;
                const f32x4 wa = *(const GAS f32x4*)(wrow + s0), wb = *(const GAS f32x4*)(wrow + s0 + 4);
                const float wv[8] = {wa.x, wa.y, wa.z, wa.w, wb.x, wb.y, wb.z, wb.w}; float wm[8];
#pragma unroll
                for (int j = 0; j < 8; ++j) wm[j] = (s0 + j <= t) ? wv[j] : 0.f;
                v4u ap; ap.x = pkc(wm[0], wm[1]); ap.y = pkc(wm[2], wm[3]); ap.z = pkc(wm[4], wm[5]); ap.w = pkc(wm[6], wm[7]);
                const bf16x8 a = __builtin_bit_cast(bf16x8, ap);
                const bf16x8 b0 = *(const LAS bf16x8*)(VNT + (32 * cc0 + r) * VNS + 16 * ks + 8 * hh);
                const bf16x8 b1 = *(const LAS bf16x8*)(VNT + (32 * (cc0 + 1) + r) * VNS + 16 * ks + 8 * hh);
                acc0 = MFMA32(a, b0, acc0); acc1 = MFMA32(a, b1, acc1);
            }
#pragma unroll
            for (int i = 0; i < 16; ++i) { const int to = 32 * tt + crow(i, hh); const float bs = b_sp[g * 128 + to];
                OUT[to * OUS + 32 * cc0 + r] = acc0[i] + bs; OUT[to * OUS + 32 * (cc0 + 1) + r] = acc1[i] + bs; }
        }
        LBAR();
#pragma unroll
        for (int i = 0; i < 4; ++i) {
            const int item = tid + 512 * i, t = item >> 4, c8 = (item & 15) * 8; const size_t m = m0 + t;
            const f32x4 s0 = *(const LAS f32x4*)(OUT + t * OUS + c8), s1 = *(const LAS f32x4*)(OUT + t * OUS + c8 + 4);
            const v4u uu = *(const GAS v4u*)(proj + m * PW + PC_UB + g * 128 + c8), zz = *(const GAS v4u*)(proj + m * PW + PC_ZB + g * 128 + c8);
            v4u o;
            o.x = pkc(bflo(uu.x) * s0.x * silu(bflo(zz.x)), bfhi(uu.x) * s0.y * silu(bfhi(zz.x)));
            o.y = pkc(bflo(uu.y) * s0.z * silu(bflo(zz.y)), bfhi(uu.y) * s0.w * silu(bfhi(zz.y)));
            o.z = pkc(bflo(uu.z) * s1.x * silu(bflo(zz.z)), bfhi(uu.z) * s1.y * silu(bfhi(zz.z)));
            o.w = pkc(bflo(uu.w) * s1.z * silu(bflo(zz.w)), bfhi(uu.w) * s1.w * silu(bfhi(zz.w)));
            *(GAS v4u*)(concat + m * MIXW + 1024 + g * 128 + c8) = o;
        }
    }
    LBAR();
}

#ifndef REP_P0
#define REP_P0 1
#endif
#ifndef REP_P1
#define REP_P1 1
#endif
#ifndef REP_P2
#define REP_P2 1
#endif
#ifndef REP_P3
#define REP_P3 1
#endif
#ifndef REP_P4
#define REP_P4 1
#endif
#ifndef A_NEW
#define A_NEW 1
#endif
#ifndef B_NEW
#define B_NEW 1
#endif
struct Args { const float* in[13]; float* out; unsigned char* ws; };
__global__ void __launch_bounds__(NWAVES * 64, 2) fwd_kernel(Args args) {
    extern __shared__ __attribute__((aligned(16))) unsigned char lds[];
    Frame F;
    F.lds = lds;
    F.tid = threadIdx.x; F.lane = F.tid & 63; F.wave = __builtin_amdgcn_readfirstlane(F.tid >> 6);
    F.G = gridDim.x; { const int bx = blockIdx.x; F.vcu = (F.G % 8 == 0) ? (bx % 8) * (F.G / 8) + bx / 8 : bx; }
    unsigned char* ws = args.ws; F.ws = ws;
    LAS unsigned char* ldsl = (LAS unsigned char*)lds;
    for (int u = F.tid; u < (LDS_BYTES - LDSCTL_OFF) / 4; u += NWAVES * 64) ((LAS unsigned*)(ldsl + LDSCTL_OFF))[u] = 0u;
    if (F.tid < 14) { const unsigned long long v = (F.tid < 13) ? (unsigned long long)args.in[F.tid < 13 ? F.tid : 0] : (unsigned long long)args.out; *(LAS unsigned long long*)(ldsl + ARG_OFF + 8 * F.tid) = v; }
    __syncthreads();
    volatile LAS unsigned* MISC = (volatile LAS unsigned*)(ldsl + MISC_OFF);
    XcdBarrier bar = xcd_barrier_post((unsigned*)(ws + WS_CTL) + CW_BAR, MISC + 8);

    for (int rep = 0; rep < REP_P0; ++rep) {
    relaunder(F); p0_prologue(F);
    xcd_barrier(bar);
    }
    for (int rep = 0; rep < REP_P1; ++rep) {
        pg8::Gemm g{((bf16*)(F.ws + WS_XN)), ((bf16*)(F.ws + WS_WT1)), M, PW, DM}; pg8::StaticOrder S; S.init(M, PW, F.G, (int)blockIdx.x);
        pg8::EpiBf16 E{((bf16*)(F.ws + WS_PROJ)), PW};
        pg8::gemm_phase<pg8::EpiBf16, pg8::StaticOrder, true, true>(ldsl + RING_OFF, g, S, E, F.wave);
        xcd_barrier(bar);
    }
    for (int rep = 0; rep < REP_P2; ++rep) {
#if A_NEW
    relaunder(F);
    for (int u = F.vcu; u < 2048; u += F.G) a_local_unit(F, u >> 9, (u >> 6) & 7, u & 63);
#else
    naive_conv_gates(F);
#endif
#if !B_NEW
    naive_lnst(F);
#endif
    xcd_barrier(bar);
    }
    for (int rep = 0; rep < REP_P3; ++rep) {
    relaunder(F);
    if (blockIdx.x < 32) {
#if A_NEW
        if (PROBE_SEL == 1 && blockIdx.x == 0 && F.tid == 0) TS_SET(F, 0, TS_NOW());
        scan_head(F, blockIdx.x >> 3, blockIdx.x & 7);
        if (PROBE_SEL == 1 && blockIdx.x == 0 && F.tid == 0) TS_SET(F, 1, TS_NOW());
#else
        naive_scan(F, blockIdx.x >> 3, blockIdx.x & 7);
#endif
    } else {
#if B_NEW
        for (int ub = blockIdx.x - 32; ub < 256; ub += F.G - 32) b_unit(F, ub >> 6, (ub >> 1) & 31, ub & 1);
#else
        naive_sgu(F, 32);
#endif
    }
    xcd_barrier(bar);
    }
#if !A_NEW
    naive_gateA(F);
    xcd_barrier(bar);
#endif
#if PROBE_SEL
    if (blockIdx.x == 0 && F.tid == 0) { const unsigned long long* ts = (const unsigned long long*)(F.ws + WS_TS); const unsigned long long d = ts[1] - ts[0];
        unsigned long long rows = d * 16384ull / (100ull * PROBE_SCALE_US); if (rows > 16384ull) rows = 16384ull; TS_SET(F, 63, rows); }
#endif
    for (int rep = 0; rep < REP_P4; ++rep) {
        pg8::Gemm g{((bf16*)(F.ws + WS_CONCAT)), ((bf16*)(F.ws + WS_WT2)), M, DM, MIXW}; pg8::StaticOrder S; S.init(M, DM, F.G, (int)blockIdx.x);
        pg8::EpiResid E{argp(F, 0), (float*)argp(F, 13), DM, ((float*)(F.ws + WS_ROWSS))};
        pg8::gemm_phase<pg8::EpiResid, pg8::StaticOrder, true, true>(ldsl + RING_OFF, g, S, E, F.wave);
        xcd_barrier(bar);
    }
    relaunder(F); p5_final(F);
}

extern "C" void kernel_launch(void* const* d_in, const int* in_sizes, int n_in, void* d_out, int out_size, void* d_ws, size_t ws_size, hipStream_t stream) {
    static int grid = 0;
    if (grid == 0) {
        int dev = 0, cus = 0;
        if (hipGetDevice(&dev) != hipSuccess || hipDeviceGetAttribute(&cus, hipDeviceAttributeMultiprocessorCount, dev) != hipSuccess) { fprintf(stderr, "kernel_launch: device query failed\n"); grid = -1; return; }
        if (hipFuncSetAttribute((const void*)fwd_kernel, hipFuncAttributeMaxDynamicSharedMemorySize, LDS_BYTES) != hipSuccess) { fprintf(stderr, "kernel_launch: hipFuncSetAttribute failed\n"); grid = -1; return; }
        int per_cu = 0;
        if (hipOccupancyMaxActiveBlocksPerMultiprocessor(&per_cu, (const void*)fwd_kernel, NWAVES * 64, LDS_BYTES) != hipSuccess || per_cu < 1) fprintf(stderr, "kernel_launch: occupancy query reports %d blocks per CU\n", per_cu);
        (void)hipGetLastError();
        grid = cus;
    }
    if (grid < 0) return;
    (void)hipMemsetAsync((char*)d_ws + WS_CTL, 0, CTL_ZERO_BYTES, stream);
    Args a{};
    for (int i = 0; i < 13; ++i) a.in[i] = (const float*)d_in[i];
    a.out = (float*)d_out; a.ws = (unsigned char*)d_ws;
    hipLaunchKernelGGL(fwd_kernel, dim3(grid), dim3(NWAVES * 64), LDS_BYTES, stream, a);
}
```
